# Optimizing an MI355X kernel written in HIP

```python
import math
import jax, jax.numpy as jnp
from jax import lax
import numpy as np

D_MODEL = 2048
BATCH = 4
SEQ = 4096
DEPTH = 2

MIX_WIDTH = D_MODEL
S5_WIDTH = MIX_WIDTH // 4
S5_GROUP = 16
S5_GROUPS = S5_WIDTH // S5_GROUP
S5_STATE = 64
DT_MIN = 1e-3
DT_MAX = 1e-1
SB_HEAD_DIM = 128
SB_HEADS = (MIX_WIDTH - S5_WIDTH) // SB_HEAD_DIM
SB_WIDTH = SB_HEADS * SB_HEAD_DIM
Q_BLOCK = 128
AB_IN_WIDTH = S5_WIDTH + 3 * SB_WIDTH
POOL_WINDOWS = (2, 4, 8, 16)
POOL_GROUPS = len(POOL_WINDOWS)
POOL_GROUP_WIDTH = MIX_WIDTH // POOL_GROUPS
N_EXPERTS = 16
N_EXPERT_GROUPS = 4
EXPERTS_PER_GROUP = N_EXPERTS // N_EXPERT_GROUPS
TOP_K = 2
D_FF_EXPERT = D_MODEL // 2
ALPHA = (2.0 * DEPTH) ** 0.25
BETA = (8.0 * DEPTH) ** -0.25
LN_EPS = 1e-5
N_EVEN = (DEPTH + 1) // 2
N_ODD = DEPTH // 2

kernel_name = "hybrid_s5_stickbreak_pool_grouped_moe_deepnorm"


def layer_norm(x, g, b):
    xf = x.astype(jnp.float32)
    mu = jnp.mean(xf, axis=-1, keepdims=True)
    var = jnp.mean(jnp.square(xf - mu), axis=-1, keepdims=True)
    y = (xf - mu) * lax.rsqrt(var + LN_EPS) * g.astype(jnp.float32) + b.astype(jnp.float32)
    return y.astype(x.dtype)


def s5_mixer(u, lam_re, lam_im, log_dt, b_re, b_im, c_re, c_im, d, w_glu, b_glu):
    Bsz, S, _ = u.shape
    uf = u.astype(jnp.float32)
    ug = uf.reshape(Bsz, S, S5_GROUPS, S5_GROUP)
    lr = lam_re.astype(jnp.float32)
    li = lam_im.astype(jnp.float32)
    dt = jnp.exp(log_dt.astype(jnp.float32))[:, None]
    mag = jnp.exp(lr * dt)
    lbr = mag * jnp.cos(li * dt)
    lbi = mag * jnp.sin(li * dt)
    den = lr * lr + li * li
    coef_re = ((lbr - 1.0) * lr + lbi * li) / den
    coef_im = (lbi * lr - (lbr - 1.0) * li) / den
    br = b_re.astype(jnp.float32)
    bi = b_im.astype(jnp.float32)
    bbar_re = coef_re[..., None] * br - coef_im[..., None] * bi
    bbar_im = coef_re[..., None] * bi + coef_im[..., None] * br
    bu_re = jnp.einsum('bsgh,gnh->bsgn', ug, bbar_re)
    bu_im = jnp.einsum('bsgh,gnh->bsgn', ug, bbar_im)
    a_re = jnp.broadcast_to(lbr, bu_re.shape)
    a_im = jnp.broadcast_to(lbi, bu_im.shape)

    def combine(e1, e2):
        a1r, a1i, b1r, b1i = e1
        a2r, a2i, b2r, b2i = e2
        ar = a2r * a1r - a2i * a1i
        ai = a2r * a1i + a2i * a1r
        b_r = a2r * b1r - a2i * b1i + b2r
        b_i = a2r * b1i + a2i * b1r + b2i
        return (ar, ai, b_r, b_i)

    _, _, s_re, s_im = lax.associative_scan(combine, (a_re, a_im, bu_re, bu_im), axis=1)
    y = (jnp.einsum('bsgn,ghn->bsgh', s_re, c_re.astype(jnp.float32))
         - jnp.einsum('bsgn,ghn->bsgh', s_im, c_im.astype(jnp.float32)))
    y = y.reshape(Bsz, S, S5_WIDTH) + d.astype(jnp.float32) * uf
    g = jax.nn.gelu(y)
    out = g * jax.nn.sigmoid(g @ w_glu.astype(jnp.float32) + b_glu.astype(jnp.float32))
    return out.astype(u.dtype)


def stick_breaking_attention(q, k, v):
    Bsz, S, H, dh = q.shape
    nb = S // Q_BLOCK
    scale = 1.0 / math.sqrt(dh)
    qh = q.astype(jnp.float32).transpose(0, 2, 1, 3)
    kh = k.astype(jnp.float32).transpose(0, 2, 1, 3)
    vh = v.astype(jnp.float32).transpose(0, 2, 1, 3)
    qb = qh.reshape(Bsz, H, nb, Q_BLOCK, dh).transpose(2, 0, 1, 3, 4)
    k_pos = jnp.arange(S)

    def block(args):
        q_blk, blk = args
        q_pos = blk * Q_BLOCK + jnp.arange(Q_BLOCK)
        causal = k_pos[None, :] < q_pos[:, None]
        z = jnp.einsum('bhqd,bhkd->bhqk', q_blk, kh) * scale
        log_beta = jax.nn.log_sigmoid(z)
        log_keep = jnp.where(causal, jax.nn.log_sigmoid(-z), 0.0)
        tail = jnp.flip(jnp.cumsum(jnp.flip(log_keep, -1), axis=-1), -1) - log_keep
        w = jnp.where(causal, jnp.exp(log_beta + tail), 0.0)
        return jnp.einsum('bhqk,bhkd->bhqd', w, vh)

    out = lax.map(block, (qb, jnp.arange(nb)))
    out = out.transpose(1, 0, 3, 2, 4).reshape(Bsz, S, H * dh)
    return out.astype(q.dtype)


def mixer_ab(x, w_in, lam_re, lam_im, log_dt, b_re, b_im, c_re, c_im, d, w_glu, b_glu, w_out):
    Bsz, S, _ = x.shape
    h = x @ w_in
    u = h[..., :S5_WIDTH]
    q = h[..., S5_WIDTH:S5_WIDTH + SB_WIDTH].reshape(Bsz, S, SB_HEADS, SB_HEAD_DIM)
    k = h[..., S5_WIDTH + SB_WIDTH:S5_WIDTH + 2 * SB_WIDTH].reshape(Bsz, S, SB_HEADS, SB_HEAD_DIM)
    v = h[..., S5_WIDTH + 2 * SB_WIDTH:].reshape(Bsz, S, SB_HEADS, SB_HEAD_DIM)
    y_a = s5_mixer(u, lam_re, lam_im, log_dt, b_re, b_im, c_re, c_im, d, w_glu, b_glu)
    y_b = stick_breaking_attention(q, k, v)
    return jnp.concatenate([y_a, y_b], axis=-1) @ w_out


def mixer_pool(x, w_in, w_group, scale, w_out):
    Bsz, S, _ = x.shape
    h = (x @ w_in).astype(jnp.float32).reshape(Bsz, S, POOL_GROUPS, POOL_GROUP_WIDTH)
    cs = jnp.cumsum(h, axis=1)
    cs0 = jnp.concatenate([jnp.zeros_like(cs[:, :1]), cs], axis=1)
    windows = jnp.array(POOL_WINDOWS, dtype=jnp.int32)
    t = jnp.arange(S, dtype=jnp.int32)[:, None]
    lo = jnp.maximum(t + 1 - windows[None, :], 0)
    g_idx = jnp.arange(POOL_GROUPS)[None, :]
    window_sum = cs0[:, 1:] - cs0[:, lo, g_idx, :]
    count = jnp.minimum(t + 1, windows[None, :]).astype(jnp.float32)
    pooled = window_sum / count[None, :, :, None] - h
    y = jnp.einsum('bsgc,gce->bsge', pooled, w_group.astype(jnp.float32))
    y = y.reshape(Bsz, S, MIX_WIDTH) * scale.astype(jnp.float32)
    return y.astype(x.dtype) @ w_out


def grouped_moe(x, router_w, router_b, w_gate, w_up, w_down):
    Bsz, S, D = x.shape
    tok = x.reshape(-1, D)
    logits = (tok @ router_w + router_b).astype(jnp.float32)
    probs = jax.nn.softmax(logits, axis=-1)
    pg = probs.reshape(-1, N_EXPERT_GROUPS, EXPERTS_PER_GROUP)
    group_score = lax.top_k(pg, TOP_K)[0].sum(-1)
    g_sel = jnp.argmax(group_score, axis=-1)
    in_group = (jnp.arange(N_EXPERTS) // EXPERTS_PER_GROUP)[None, :] == g_sel[:, None]
    masked = jnp.where(in_group, probs, -1.0)
    top_w, top_i = lax.top_k(masked, TOP_K)
    top_w = top_w / jnp.sum(top_w, axis=-1, keepdims=True)
    gates = jnp.einsum('tk,tke->te', top_w, jax.nn.one_hot(top_i, N_EXPERTS, dtype=jnp.float32))
    gates = gates.astype(tok.dtype)
    out = jnp.zeros_like(tok)
    for e in range(N_EXPERTS):
        hid = jax.nn.silu(tok @ w_gate[e]) * (tok @ w_up[e])
        out = out + gates[:, e:e + 1] * (hid @ w_down[e])
    return out.reshape(Bsz, S, D)


def setup_inputs(seed: int = 0) -> dict:
    key = jax.random.key(seed)
    ks = jax.random.split(key, 26)
    f32 = jnp.float32
    nrm = lambda k, shape, s: jax.random.normal(k, shape, f32) * s
    x = jax.random.normal(ks[0], (BATCH, SEQ, D_MODEL), f32)
    ab_w_in = nrm(ks[1], (N_EVEN, D_MODEL, AB_IN_WIDTH), D_MODEL ** -0.5)
    n_idx = jnp.arange(S5_STATE, dtype=f32)
    ab_lambda_re = -0.5 + nrm(ks[2], (N_EVEN, S5_GROUPS, S5_STATE), 0.01)
    ab_lambda_im = math.pi * n_idx + nrm(ks[3], (N_EVEN, S5_GROUPS, S5_STATE), 0.01)
    ab_log_dt = jax.random.uniform(ks[4], (N_EVEN, S5_GROUPS), f32, math.log(DT_MIN), math.log(DT_MAX))
    ab_b_re = nrm(ks[5], (N_EVEN, S5_GROUPS, S5_STATE, S5_GROUP), (2 * S5_GROUP) ** -0.5)
    ab_b_im = nrm(ks[6], (N_EVEN, S5_GROUPS, S5_STATE, S5_GROUP), (2 * S5_GROUP) ** -0.5)
    ab_c_re = nrm(ks[7], (N_EVEN, S5_GROUPS, S5_GROUP, S5_STATE), (2 * S5_STATE) ** -0.5)
    ab_c_im = nrm(ks[8], (N_EVEN, S5_GROUPS, S5_GROUP, S5_STATE), (2 * S5_STATE) ** -0.5)
    ab_d = 1.0 + nrm(ks[9], (N_EVEN, S5_WIDTH), 0.1)
    ab_w_glu = nrm(ks[10], (N_EVEN, S5_WIDTH, S5_WIDTH), S5_WIDTH ** -0.5)
    ab_b_glu = nrm(ks[11], (N_EVEN, S5_WIDTH), 0.01)
    ab_w_out = nrm(ks[12], (N_EVEN, MIX_WIDTH, D_MODEL), BETA * MIX_WIDTH ** -0.5)
    c_w_in = nrm(ks[13], (N_ODD, D_MODEL, MIX_WIDTH), D_MODEL ** -0.5)
    c_w_group = nrm(ks[14], (N_ODD, POOL_GROUPS, POOL_GROUP_WIDTH, POOL_GROUP_WIDTH), POOL_GROUP_WIDTH ** -0.5)
    c_scale = 1.0 + nrm(ks[15], (N_ODD, MIX_WIDTH), 0.02)
    c_w_out = nrm(ks[16], (N_ODD, MIX_WIDTH, D_MODEL), BETA * MIX_WIDTH ** -0.5)
    ln_g = 1.0 + nrm(ks[17], (DEPTH, 2, D_MODEL), 0.02)
    ln_b = nrm(ks[18], (DEPTH, 2, D_MODEL), 0.02)
    router_w = nrm(ks[19], (D_MODEL, N_EXPERTS), D_MODEL ** -0.5)
    router_b = nrm(ks[20], (N_EXPERTS,), 0.01)
    moe_w_gate = nrm(ks[21], (DEPTH, N_EXPERTS, D_MODEL, D_FF_EXPERT), D_MODEL ** -0.5)
    moe_w_up = nrm(ks[22], (DEPTH, N_EXPERTS, D_MODEL, D_FF_EXPERT), D_MODEL ** -0.5)
    moe_w_down = nrm(ks[23], (DEPTH, N_EXPERTS, D_FF_EXPERT, D_MODEL), BETA * D_FF_EXPERT ** -0.5)
    return {"x": x, "ab_w_in": ab_w_in, "ab_lambda_re": ab_lambda_re, "ab_lambda_im": ab_lambda_im,
            "ab_log_dt": ab_log_dt, "ab_b_re": ab_b_re, "ab_b_im": ab_b_im, "ab_c_re": ab_c_re,
            "ab_c_im": ab_c_im, "ab_d": ab_d, "ab_w_glu": ab_w_glu, "ab_b_glu": ab_b_glu,
            "ab_w_out": ab_w_out, "c_w_in": c_w_in, "c_w_group": c_w_group, "c_scale": c_scale,
            "c_w_out": c_w_out, "ln_g": ln_g, "ln_b": ln_b, "router_w": router_w, "router_b": router_b,
            "moe_w_gate": moe_w_gate, "moe_w_up": moe_w_up, "moe_w_down": moe_w_down}


def reference(x, ab_w_in, ab_lambda_re, ab_lambda_im, ab_log_dt, ab_b_re, ab_b_im, ab_c_re, ab_c_im,
              ab_d, ab_w_glu, ab_b_glu, ab_w_out, c_w_in, c_w_group, c_scale, c_w_out, ln_g, ln_b,
              router_w, router_b, moe_w_gate, moe_w_up, moe_w_down):
    h = x
    for i in range(DEPTH):
        j = i // 2
        if i % 2 == 0:
            mix = mixer_ab(h, ab_w_in[j], ab_lambda_re[j], ab_lambda_im[j], ab_log_dt[j], ab_b_re[j],
                           ab_b_im[j], ab_c_re[j], ab_c_im[j], ab_d[j], ab_w_glu[j], ab_b_glu[j], ab_w_out[j])
        else:
            mix = mixer_pool(h, c_w_in[j], c_w_group[j], c_scale[j], c_w_out[j])
        h = layer_norm(ALPHA * h + mix, ln_g[i, 0], ln_b[i, 0])
        ffn = grouped_moe(h, router_w, router_b, moe_w_gate[i], moe_w_up[i], moe_w_down[i])
        h = layer_norm(ALPHA * h + ffn, ln_g[i, 1], ln_b[i, 1])
    return h
```

```cpp
#include <hip/hip_runtime.h>
#include <cstdio>
#include <cstdint>

namespace {
constexpr size_t MiB = 1u << 20;
#define LAS __attribute__((address_space(3)))
#define GAS __attribute__((address_space(1)))
typedef unsigned short bf16_t;
typedef short bf16x8 __attribute__((ext_vector_type(8)));
typedef float f32x4 __attribute__((ext_vector_type(4)));
typedef float f32x2 __attribute__((ext_vector_type(2)));
typedef float f32x16 __attribute__((ext_vector_type(16)));
typedef unsigned u32x4 __attribute__((ext_vector_type(4)));
typedef unsigned u32x2 __attribute__((ext_vector_type(2)));
#define LDS_WAIT() asm volatile("s_waitcnt lgkmcnt(0)" ::: "memory")
#define VM_WAIT() asm volatile("s_waitcnt vmcnt(0)" ::: "memory")
#define DI __device__ __forceinline__

DI unsigned f2bf(float f) { unsigned u = __builtin_bit_cast(unsigned, f); return (u + 0x7fffu + ((u >> 16) & 1u)) >> 16; }

DI unsigned pk2(float lo, float hi);
DI float bf2f(unsigned short b) { return __builtin_bit_cast(float, ((unsigned)b) << 16); }
DI float bflo(unsigned w) { return __builtin_bit_cast(float, w << 16); }
DI float bfhi(unsigned w) { return __builtin_bit_cast(float, w & 0xffff0000u); }
typedef __bf16 hwbf16x2 __attribute__((ext_vector_type(2)));
DI unsigned cvt_pk_bf16(float lo, float hi) { const f32x2 v = {lo, hi}; return __builtin_bit_cast(unsigned, __builtin_convertvector(v, hwbf16x2)); }

namespace fg {
constexpr int BM = 256, BK = 64, HALF = 128, HTB = HALF * BK * 2, STAGE_BYTES = 8 * HTB, NXCD = 8, WGM = 8;
__host__ __device__ __forceinline__ int lds_byte(int r, int c) { const int st = (r >> 4) * 2 + (c >> 5), rr = r & 15, cc = c & 31, ob = rr * 64 + cc * 2; return st * 1024 + (ob ^ (((ob >> 9) & 1) << 5)); }
__host__ __device__ __forceinline__ void stage_rc(int b, int& R, int& C) { const int st = b / 1024, sb = b % 1024, swz = sb ^ (((sb >> 9) & 1) << 5); R = (st >> 1) * 16 + swz / 64; C = (st & 1) * 32 + (swz % 64) / 2; }
__host__ __device__ __forceinline__ int perm32(int rho) { const int n = rho >> 4, i = rho & 15; return 8 * (i >> 2) + 4 * n + (i & 3); }

struct Unit { const char* a; const char* b; int pm, pn, e, lim; };

DI void tile_of(int wgid, int nM, int nN, int& pm, int& pn) {
    const int nwg = nM * nN;
    { const int q = nwg / NXCD, r = nwg % NXCD, xcd = wgid % NXCD, off = wgid / NXCD; wgid = (xcd < r ? xcd * (q + 1) : r * (q + 1) + (xcd - r) * q) + off; }
    const int nig = WGM * nN, gid = wgid / nig, fm = gid * WGM, gsz = (nM - fm) < WGM ? (nM - fm) : WGM;
    pm = fm + ((wgid % nig) % gsz); pn = (wgid % nig) / gsz;
}
struct PlainSched {
    const char* A; const char* B; int lda, ldb, nM, nN, G, c, apn_div; long apn_bytes;
    DI bool next(int i, Unit& u) const {
        const long L = (long)i * G + c; if (L >= (long)nM * nN) return false;
        int pm, pn; tile_of((int)L, nM, nN, pm, pn);
        u.pm = pm; u.pn = pn; u.e = 0; u.lim = 256;
        u.a = A + (size_t)pm * 256 * lda * 2 + (size_t)(pn / apn_div) * apn_bytes; u.b = B + (size_t)pn * 256 * ldb * 2; return true;
    }
    DI int arow(const Unit&, int R) const { return R; }
    DI void a_ready(const Unit&) const {}
    DI void done(const Unit&) const {}
};
struct FoldSched {
    const char* A; const char* B; int u;
    DI bool next(int i, Unit& un) const {
        if (i > 0) return false;
        const int g = u >> 4, pm2 = (u >> 3) & 1, pn = u & 7;
        un.pm = 2 * g + pm2; un.pn = pn; un.e = 0; un.lim = 256;
        un.a = A + (size_t)(g * 512 + pm2 * 256) * 512 * 2; un.b = B + ((size_t)pn * 256 * 2048 + g * 512) * 2; return true;
    }
    DI int arow(const Unit&, int R) const { return R; }
    DI void a_ready(const Unit&) const {}
    DI void done(const Unit&) const {}
};
struct MoeSched {
    const char* A; const char* B; long b_estride; int lda, ldb, nN, G, c; const volatile LAS int* pre; const int* cnt; const int* list; int gather; unsigned* ready; int dep;
    DI bool next(int i, Unit& u) const {
        const int nM = pre[16]; const long L = (long)i * G + c; if (L >= (long)nM * nN) return false;
        int pm, pn; tile_of((int)L, nM, nN, pm, pn);
        int e = 0;
#pragma unroll
        for (int j = 1; j < 16; ++j) e += (pm >= pre[j]) ? 1 : 0;
        const int mt = pm - pre[e]; const int lim = cnt[e] - mt * 256;
        u.pm = pm; u.pn = pn; u.e = e; u.lim = lim < 256 ? lim : 256;
        u.a = gather ? A : A + (size_t)pm * 256 * lda * 2; u.b = B + (size_t)e * b_estride + (size_t)pn * 256 * ldb * 2; return true;
    }
    DI int arow(const Unit& u, int R) const {
        const int mt = u.pm - pre[u.e];
        return (R < u.lim) ? list[u.e * 16384 + mt * 256 + R] : 0;
    }
    DI void done(const Unit& u) const {
        if (dep == 1) {
            asm volatile("s_waitcnt vmcnt(0)" ::: "memory");
            asm volatile("" ::: "memory"); __builtin_amdgcn_s_barrier(); asm volatile("" ::: "memory");
            if (threadIdx.x == 0) __hip_atomic_fetch_add(ready + 64 * u.pm, 1u, __ATOMIC_RELAXED, __HIP_MEMORY_SCOPE_AGENT);
        }
    }
    DI void a_ready(const Unit& u) const {
        if (dep == 2) {
            if (threadIdx.x < 64) {
                unsigned polls = 0;
                while ((unsigned)__builtin_amdgcn_readfirstlane(__hip_atomic_load(ready + 64 * u.pm, __ATOMIC_RELAXED, __HIP_MEMORY_SCOPE_AGENT)) < 8u) {
                    __builtin_amdgcn_s_sleep(2); if (++polls > (1u << 22)) break; }
                __builtin_amdgcn_fence(__ATOMIC_ACQUIRE, "agent");
                asm volatile("s_waitcnt vmcnt(0)" ::: "memory");
            }
            asm volatile("" ::: "memory"); __builtin_amdgcn_s_barrier(); asm volatile("" ::: "memory");
        }
    }
};

struct EpiF32 {
    static constexpr bool PERM = false;
    float* C; int ldc;
    DI void operator()(const f32x4 (&acc)[2][2][4][2], const Unit& u, int wr, int wc, int fr, int fq) const {
        const int row0 = u.pm * BM + wr * 64 + fr, col0 = u.pn * BM + wc * 32 + 4 * fq;
#pragma unroll
        for (int ai = 0; ai < 2; ++ai)
#pragma unroll
            for (int m = 0; m < 4; ++m) { float* rowp = C + (size_t)(row0 + ai * HALF + m * 16) * ldc + col0;
#pragma unroll
                for (int bj = 0; bj < 2; ++bj)
#pragma unroll
                    for (int n = 0; n < 2; ++n) *(f32x4*)(rowp + bj * HALF + n * 16) = acc[ai][bj][m][n]; }
    }
};
template <int MODE  > struct EpiBf16 {
    static constexpr bool PERM = true;
    bf16_t* O; int ldc; const float* cs; const bf16_t* Gm; int ldg;
    DI void operator()(const f32x4 (&acc)[2][2][4][2], const Unit& u, int wr, int wc, int fr, int fq) const {
        const int row0 = u.pm * BM + wr * 64 + fr; const int col0 = u.pn * BM + wc * 32 + 8 * fq;
        f32x4 cv[2][2];
#pragma unroll
        for (int bj = 0; bj < 2; ++bj)
#pragma unroll
            for (int n = 0; n < 2; ++n) cv[bj][n] = (MODE == 1 || MODE == 2) ? *(const f32x4*)(cs + col0 + bj * HALF + 4 * n) : (f32x4){0.f, 0.f, 0.f, 0.f};
#pragma unroll
        for (int ai = 0; ai < 2; ++ai)
#pragma unroll
            for (int m = 0; m < 4; ++m) { const size_t row = (size_t)(row0 + ai * HALF + m * 16); bf16_t* rowp = O + row * ldc + col0;
#pragma unroll
                for (int bj = 0; bj < 2; ++bj) { f32x4 v0 = acc[ai][bj][m][0], v1 = acc[ai][bj][m][1];
                    if (MODE == 1) { v0 = v0 * cv[bj][0]; v1 = v1 * cv[bj][1]; }
                    if (MODE == 3) { const float rs = cs[row]; v0 = v0 * rs; v1 = v1 * rs; }
                    if (MODE == 4) {
                        const u32x4 gw = *(const u32x4*)(Gm + row * ldg + col0 + bj * HALF);
                        v0 = v0 + 1.41421356237309515f * (f32x4){bflo(gw.x), bfhi(gw.x), bflo(gw.y), bfhi(gw.y)}; v1 = v1 + 1.41421356237309515f * (f32x4){bflo(gw.z), bfhi(gw.z), bflo(gw.w), bfhi(gw.w)};
                    }
                    if (MODE == 2) {
                        const u32x4 gw = *(const u32x4*)(Gm + row * ldg + col0 + bj * HALF);
                        v0 = v0 + cv[bj][0]; v1 = v1 + cv[bj][1];
                        const float g[8] = {bflo(gw.x), bfhi(gw.x), bflo(gw.y), bfhi(gw.y), bflo(gw.z), bfhi(gw.z), bflo(gw.w), bfhi(gw.w)};
#pragma unroll
                        for (int j = 0; j < 4; ++j) { v0[j] = g[j] * __builtin_amdgcn_rcpf(1.f + __expf(-v0[j])); v1[j] = g[4 + j] * __builtin_amdgcn_rcpf(1.f + __expf(-v1[j])); }
                    }
                    u32x4 w; w.x = cvt_pk_bf16(v0[0], v0[1]); w.y = cvt_pk_bf16(v0[2], v0[3]); w.z = cvt_pk_bf16(v1[0], v1[1]); w.w = cvt_pk_bf16(v1[2], v1[3]);
                    *(u32x4*)(rowp + bj * HALF) = w; } }
    }
};
struct EpiSwiGlu {
    static constexpr bool PERM = false;
    bf16_t* Hd;
    DI void operator()(const f32x4 (&acc)[2][2][4][2], const Unit& u, int wr, int wc, int fr, int fq) const {
        const int row0 = u.pm * BM + wr * 64 + fr; const int col0 = u.pn * 128 + wc * 16 + 4 * fq;
#pragma unroll
        for (int ai = 0; ai < 2; ++ai)
#pragma unroll
            for (int m = 0; m < 4; ++m) { bf16_t* rowp = Hd + (size_t)(row0 + ai * HALF + m * 16) * 1024 + col0;
#pragma unroll
                for (int bj = 0; bj < 2; ++bj) { const f32x4 g = acc[ai][bj][m][0], up = acc[ai][bj][m][1]; f32x4 h;
#pragma unroll
                    for (int j = 0; j < 4; ++j) h[j] = g[j] * __builtin_amdgcn_rcpf(1.f + __expf(-g[j])) * up[j];
                    u32x2 w; w.x = cvt_pk_bf16(h[0], h[1]); w.y = cvt_pk_bf16(h[2], h[3]);
                    *(u32x2*)(rowp + bj * 64) = w; } }
    }
};
struct EpiScatter {
    static constexpr bool PERM = true;
    bf16_t* F; const int* crow; const volatile LAS int* pre;
    DI void operator()(const f32x4 (&acc)[2][2][4][2], const Unit& u, int wr, int wc, int fr, int fq) const {
        const int mt = u.pm - pre[u.e]; const int col0 = u.pn * BM + wc * 32 + 8 * fq;
#pragma unroll
        for (int ai = 0; ai < 2; ++ai)
#pragma unroll
            for (int m = 0; m < 4; ++m) { const int R = ai * HALF + wr * 64 + m * 16 + fr;
                if (R < u.lim) { const int dst = crow[u.e * 16384 + mt * 256 + R]; bf16_t* rowp = F + (size_t)dst * 2048 + col0;
#pragma unroll
                    for (int bj = 0; bj < 2; ++bj) { const f32x4 v0 = acc[ai][bj][m][0], v1 = acc[ai][bj][m][1];
                        u32x4 w; w.x = cvt_pk_bf16(v0[0], v0[1]); w.y = cvt_pk_bf16(v0[2], v0[3]); w.z = cvt_pk_bf16(v1[0], v1[1]); w.w = cvt_pk_bf16(v1[2], v1[3]);
                        *(u32x4*)(rowp + bj * HALF) = w; } } }
    }
};

template <class Epi, class Sched, bool GATHER>
__device__ __forceinline__ void gemm_phase(LAS unsigned char* lds, const int lda, const int ldb, const int K, const Sched& S, const Epi& E) {
    int tid_ = threadIdx.x; asm volatile("" : "+v"(tid_));
    const int tid = tid_, wid = __builtin_amdgcn_readfirstlane(tid >> 6), lane = tid & 63, wr = wid >> 2, wc = wid & 3, fr = lane & 15, fq = lane >> 4;
    const int nt = K / BK;
    Unit cur, nxt; int ui = 0;
    if (!S.next(0, cur)) return;
    unsigned voffA[2][2], voffB[2];
#pragma unroll
    for (int i = 0; i < 2; ++i) { int R, C; stage_rc(tid * 16 + i * 8192, R, C); const int Rb = Epi::PERM ? ((R & ~31) + perm32(R & 31)) : R;
        voffB[i] = (unsigned)(Rb * ldb + C) * 2u;
#pragma unroll
        for (int h = 0; h < 2; ++h) voffA[h][i] = (unsigned)((GATHER ? S.arow(cur, R + 128 * h) : (R + 128 * h)) * lda + C) * 2u; }
    const size_t kstep = (size_t)(BK * 2);
    const size_t hstepB = (size_t)HALF * ldb * 2;
    const unsigned ldsw = (unsigned)wid * 1024u;
    const int aoff = lds_byte(wr * 64 + fr, fq * 8), boff = lds_byte(wc * 32 + fr, fq * 8);
#define PG8_SA(b, h) (((b) * 2 + (h)) * HTB)
#define PG8_SB(b, h) ((4 + (b) * 2 + (h)) * HTB)
#define PG8_STAGE(bufoff, gbase, voff) do { _Pragma("unroll") for (int _i = 0; _i < 2; ++_i) \
        __builtin_amdgcn_global_load_lds((const unsigned*)((const char*)(gbase) + (voff)[_i]), (LAS unsigned*)(lds + (bufoff) + ldsw + _i * 8192), 16, 0, 0); } while (0)
#define PG8_LDA(dst, b, h) do { _Pragma("unroll") for (int m = 0; m < 4; ++m) _Pragma("unroll") for (int k = 0; k < 2; ++k) dst[m][k] = *(const LAS bf16x8*)(lds + PG8_SA(b, h) + aoff + m * 2048 + k * 1024); } while (0)
#define PG8_LDB(dst, b, h) do { _Pragma("unroll") for (int n = 0; n < 2; ++n) _Pragma("unroll") for (int k = 0; k < 2; ++k) dst[n][k] = *(const LAS bf16x8*)(lds + PG8_SB(b, h) + boff + n * 2048 + k * 1024); } while (0)
#define PG8_MMA(ai, bj, At, Bt) do { if (need[ai]) { __builtin_amdgcn_s_setprio(1); _Pragma("unroll") for (int m = 0; m < 4; ++m) _Pragma("unroll") for (int n = 0; n < 2; ++n) _Pragma("unroll") for (int k = 0; k < 2; ++k) \
        acc[ai][bj][m][n] = __builtin_amdgcn_mfma_f32_16x16x32_bf16(Bt[n][k], At[m][k], acc[ai][bj][m][n], 0, 0, 0); __builtin_amdgcn_s_setprio(0); } } while (0)
#define PG8_WAIT_V(n) asm volatile("s_waitcnt vmcnt(" #n ")" ::: "memory")
#define PG8_WAIT_L(n) asm volatile("s_waitcnt lgkmcnt(" #n ")" ::: "memory")
#define PG8_BAR __builtin_amdgcn_s_barrier()
#define PG8_SCHED __builtin_amdgcn_sched_barrier(0)
    f32x4 acc[2][2][4][2];
#pragma unroll
    for (int a = 0; a < 2; ++a)
#pragma unroll
        for (int b = 0; b < 2; ++b)
#pragma unroll
            for (int m = 0; m < 4; ++m)
#pragma unroll
                for (int n = 0; n < 2; ++n) acc[a][b][m][n] = (f32x4){0.f, 0.f, 0.f, 0.f};
    bf16x8 At[4][2], B0[2][2], B1[2][2];
    const char* cA = cur.a; const char* cB = cur.b;
    bool need[2] = {64 * wr < cur.lim, 128 + 64 * wr < cur.lim};
    S.a_ready(cur);
    PG8_STAGE(PG8_SB(0, 0), cB, voffB); PG8_STAGE(PG8_SB(0, 1), cB + hstepB, voffB); PG8_STAGE(PG8_SA(0, 0), cA, voffA[0]); PG8_STAGE(PG8_SA(0, 1), cA, voffA[1]);
    if (wr == 1) PG8_BAR;
    PG8_WAIT_V(2); PG8_BAR;
    PG8_STAGE(PG8_SB(1, 0), cB + kstep, voffB); PG8_STAGE(PG8_SA(1, 0), cA + kstep, voffA[0]); PG8_STAGE(PG8_SB(1, 1), cB + hstepB + kstep, voffB);
    PG8_WAIT_V(6); PG8_BAR;
    for (;;) {
        const bool has_next = S.next(ui + 1, nxt);
        const char* nA = has_next ? nxt.a : cA; const char* nB = has_next ? nxt.b : cB;
        for (int t = 0; t < nt; t += 2) {
            const bool last = (t == nt - 2);
            const char* a1 = cA + (size_t)(t + 1) * kstep;
            const char* a2 = last ? nA : cA + (size_t)(t + 2) * kstep; const char* b2 = last ? nB : cB + (size_t)(t + 2) * kstep;
            const char* a3 = a2 + kstep; const char* b3 = b2 + kstep;
            if (last && has_next) S.a_ready(nxt);
            PG8_LDB(B0, 0, 0); PG8_LDB(B1, 0, 1); PG8_SCHED; PG8_LDA(At, 0, 0); PG8_STAGE(PG8_SA(1, 1), a1, voffA[1]);
            PG8_WAIT_V(8); PG8_WAIT_L(0); PG8_BAR; PG8_MMA(0, 0, At, B0); PG8_MMA(0, 1, At, B1); PG8_BAR; PG8_SCHED;
            if (GATHER) { if (last && has_next) {
#pragma unroll
                for (int i = 0; i < 2; ++i) { int R, C; stage_rc(tid * 16 + i * 8192, R, C);
#pragma unroll
                    for (int h = 0; h < 2; ++h) voffA[h][i] = (unsigned)(S.arow(nxt, R + 128 * h) * lda + C) * 2u; } } }
            PG8_LDA(At, 0, 1); PG8_STAGE(PG8_SB(0, 0), b2, voffB); PG8_STAGE(PG8_SB(0, 1), b2 + hstepB, voffB); PG8_STAGE(PG8_SA(0, 0), a2, voffA[0]);
            PG8_WAIT_V(8); PG8_WAIT_L(0); PG8_BAR; PG8_MMA(1, 0, At, B0); PG8_MMA(1, 1, At, B1); PG8_BAR; PG8_SCHED;
            PG8_LDB(B0, 1, 0); PG8_LDB(B1, 1, 1); PG8_SCHED; PG8_LDA(At, 1, 0); PG8_STAGE(PG8_SA(0, 1), a2, voffA[1]);
            PG8_WAIT_V(8); PG8_WAIT_L(0); PG8_BAR; PG8_MMA(0, 0, At, B0); PG8_MMA(0, 1, At, B1); PG8_BAR; PG8_SCHED;
            PG8_LDA(At, 1, 1); PG8_STAGE(PG8_SB(1, 0), b3, voffB); PG8_STAGE(PG8_SB(1, 1), b3 + hstepB, voffB); PG8_STAGE(PG8_SA(1, 0), a3, voffA[0]);
            PG8_WAIT_V(8); PG8_WAIT_L(0); PG8_BAR; PG8_MMA(1, 0, At, B0); PG8_MMA(1, 1, At, B1); PG8_BAR; PG8_SCHED;
        }
        if (wr == 0) PG8_BAR;
        E(acc, cur, wr, wc, fr, fq); S.done(cur);
        if (!has_next) break;
#pragma unroll
        for (int a = 0; a < 2; ++a)
#pragma unroll
            for (int b = 0; b < 2; ++b)
#pragma unroll
                for (int m = 0; m < 4; ++m)
#pragma unroll
                    for (int n = 0; n < 2; ++n) acc[a][b][m][n] = (f32x4){0.f, 0.f, 0.f, 0.f};
        cur = nxt; cA = nA; cB = nB; ++ui; need[0] = 64 * wr < cur.lim; need[1] = 128 + 64 * wr < cur.lim;
        if (wr == 1) PG8_BAR;
    }
    PG8_WAIT_V(0);
    PG8_BAR;
#undef PG8_SA
#undef PG8_SB
#undef PG8_STAGE
#undef PG8_LDA
#undef PG8_LDB
#undef PG8_MMA
#undef PG8_WAIT_V
#undef PG8_WAIT_L
#undef PG8_BAR
#undef PG8_SCHED
}
}

DI unsigned pk2(float lo, float hi) { return cvt_pk_bf16(lo, hi); }
#define MFMA32(a, b, c) __builtin_amdgcn_mfma_f32_32x32x16_bf16((a), (b), (c), 0, 0, 0)
DI bf16x8 pack8(float x0, float x1, float x2, float x3, float x4, float x5, float x6, float x7) {
    u32x4 p; p.x = cvt_pk_bf16(x0, x1); p.y = cvt_pk_bf16(x2, x3); p.z = cvt_pk_bf16(x4, x5); p.w = cvt_pk_bf16(x6, x7);
    return __builtin_bit_cast(bf16x8, p);
}
constexpr float SB_EXIT = -36.8f;

DI void attn_stage(const bf16_t* Hb, LAS unsigned char* scr, int b, int h, int key0, int lane_in) {
    int lane = lane_in; asm volatile("" : "+v"(lane));
#pragma unroll
    for (int i = 0; i < 8; ++i) {
        const int rr = 4 * i + (lane >> 4), lc = (lane & 15) ^ (rr & 15);
        const int pir = (rr & ~12) | ((rr & 4) << 1) | ((rr & 8) >> 1);
        __builtin_amdgcn_global_load_lds((const unsigned*)(Hb + (size_t)(b * 4096 + key0 + pir) * 5120 + 2048 + h * 128 + lc * 8), (LAS unsigned*)(scr + i * 1024), 16, 0, 0);
    }
#pragma unroll
    for (int i = 0; i < 8; ++i) {
        const int rw = 4 * i + (lane >> 4), lc = (lane & 15) ^ (((rw & 3) << 2) | ((rw >> 2) & 3));
        __builtin_amdgcn_global_load_lds((const unsigned*)(Hb + (size_t)(b * 4096 + key0 + rw) * 5120 + 3584 + h * 128 + lc * 8), (LAS unsigned*)(scr + 8192 + i * 1024), 16, 0, 0);
    }
}
typedef short s16x4 __attribute__((ext_vector_type(4)));
DI s16x4 v_tr_read(LAS unsigned char* vimg, int lane, int dt, int s, int t) {
    const int hh = lane >> 5, blk = (lane >> 4) & 1, q = (lane & 15) >> 2, p = lane & 3;
    const int row = 16 * s + 8 * hh + 4 * t + q, ch = 4 * dt + 2 * blk + (p >> 1);
    const int off = 256 * row + 16 * (ch ^ (((row & 3) << 2) | ((row >> 2) & 3))) + 8 * (p & 1);
    return __builtin_amdgcn_ds_read_tr16_b64_v4i16((LAS s16x4*)(vimg + off));
}
template <bool DIAG>
DI bool attn_tile(const bf16_t* Hb, LAS unsigned char* scr, const bf16x8 (&qf)[8], f32x16 (&o)[4], float& R, int b, int h, int kt, int qpos, int lane, const LAS unsigned char* kaddr, int ksw, int hh) {
    const int key0 = kt * 32;
    const float scale2 = 0.08838834764831845f * 1.4426950408889634f;
    asm volatile("s_waitcnt vmcnt(0)" ::: "memory");
    bf16x8 kf[8], vf[4][2];
#pragma unroll
    for (int ks = 0; ks < 8; ++ks) kf[ks] = *(const LAS bf16x8*)(kaddr + (((2 * ks + hh) ^ ksw) << 4));
#pragma unroll
    for (int dt = 0; dt < 4; ++dt)
#pragma unroll
        for (int s = 0; s < 2; ++s) { const s16x4 lo = v_tr_read(scr + 8192, lane, dt, s, 0), hi = v_tr_read(scr + 8192, lane, dt, s, 1);
            vf[dt][s] = __builtin_shufflevector(lo, hi, 0, 1, 2, 3, 4, 5, 6, 7); }
    asm volatile("s_waitcnt lgkmcnt(0)" ::: "memory");
    if (kt > 0) attn_stage(Hb, scr, b, h, key0 - 32, lane);
    f32x16 st;
#pragma unroll
    for (int i = 0; i < 16; ++i) st[i] = 0.f;
#pragma unroll
    for (int ks = 0; ks < 8; ++ks) st = MFMA32(kf[ks], qf[ks], st);
    float z[16], lk[16];
#pragma unroll
    for (int i = 0; i < 16; ++i) {
        z[i] = st[i] * scale2;
        const float sp = fmaxf(z[i], 0.f) + __builtin_amdgcn_logf(1.f + __builtin_amdgcn_exp2f(-fabsf(z[i])));
        if (DIAG) { const bool valid = key0 + 16 * (i >> 3) + 8 * hh + (i & 7) < qpos; lk[i] = valid ? -sp : 0.f; z[i] = valid ? z[i] : -1e30f; }
        else lk[i] = -sp;
    }
#pragma unroll
    for (int i = 6; i >= 0; --i) { lk[i] += lk[i + 1]; lk[8 + i] += lk[8 + i + 1]; }
    const float tA = lk[0], tB = lk[8];
    const float pA = __shfl_xor(tA, 32), pB = __shfl_xor(tB, 32);
    const float offB = hh ? 0.f : pB;
    const float offA = hh ? (tB + pB) : (pB + tB + pA);
    const float cA = R + offA, cB = R + offB;
    float w[16];
#pragma unroll
    for (int i = 0; i < 8; ++i) { w[i] = __builtin_amdgcn_exp2f(z[i] + lk[i] + cA); w[8 + i] = __builtin_amdgcn_exp2f(z[8 + i] + lk[8 + i] + cB); }
    R += (tA + tB) + (pA + pB);
    const bf16x8 p0 = pack8(w[0], w[1], w[2], w[3], w[4], w[5], w[6], w[7]);
    const bf16x8 p1 = pack8(w[8], w[9], w[10], w[11], w[12], w[13], w[14], w[15]);
#pragma unroll
    for (int dt = 0; dt < 4; ++dt) { o[dt] = MFMA32(vf[dt][0], p0, o[dt]); o[dt] = MFMA32(vf[dt][1], p1, o[dt]); }
    return __builtin_amdgcn_ballot_w64(R >= SB_EXIT * 1.4426950408889634f) == 0ull;
}
DI void attn_load_q(const bf16_t* Hb, int b, int h, int qb, int lane, bf16x8 (&qf)[8]) {
    const bf16_t* qrow = Hb + (size_t)(b * 4096 + qb * 32 + (lane & 31)) * 5120 + 512 + h * 128 + 8 * (lane >> 5);
#pragma unroll
    for (int ks = 0; ks < 8; ++ks) qf[ks] = *(const bf16x8*)(qrow + 16 * ks);
}
DI void attn_task(const bf16_t* Hb, bf16_t* Y, int ldy, int ycol0, LAS unsigned char* scr, int b, int h, int qb, int lane, bf16x8 (&qf)[8], bool has_next, int nb, int nh, int nqb) {
    const int r = lane & 31, hh = lane >> 5;
    const int t0 = qb * 32;
    f32x16 o[4];
#pragma unroll
    for (int dt = 0; dt < 4; ++dt)
#pragma unroll
        for (int i = 0; i < 16; ++i) o[dt][i] = 0.f;
    float R = 0.f;
    const int qpos = t0 + r;
    const LAS unsigned char* kaddr = scr + r * 256; const int ksw = r & 15;
    if (!attn_tile<true>(Hb, scr, qf, o, R, b, h, qb, qpos, lane, kaddr, ksw, hh))
        for (int kt = qb - 1; kt >= 0; --kt) if (attn_tile<false>(Hb, scr, qf, o, R, b, h, kt, qpos, lane, kaddr, ksw, hh)) break;
    asm volatile("s_waitcnt vmcnt(0)" ::: "memory");
    u32x2 wv[4][4];
#pragma unroll
    for (int dt = 0; dt < 4; ++dt)
#pragma unroll
        for (int g4 = 0; g4 < 4; ++g4) { wv[dt][g4].x = cvt_pk_bf16(o[dt][4 * g4], o[dt][4 * g4 + 1]); wv[dt][g4].y = cvt_pk_bf16(o[dt][4 * g4 + 2], o[dt][4 * g4 + 3]); }
    __builtin_amdgcn_sched_barrier(0);
    if (has_next) { attn_stage(Hb, scr, nb, nh, nqb * 32, lane); attn_load_q(Hb, nb, nh, nqb, lane, qf); }
    __builtin_amdgcn_sched_barrier(0);
    bf16_t* yrow = Y + (size_t)(b * 4096 + t0 + r) * ldy + ycol0 + h * 128 + 4 * hh;
#pragma unroll
    for (int dt = 0; dt < 4; ++dt)
#pragma unroll
        for (int g4 = 0; g4 < 4; ++g4) *(u32x2*)(yrow + 32 * dt + 8 * g4) = wv[dt][g4];
}
constexpr int NWAVES = 8;
constexpr int RING_BYTES = 131072;
constexpr int WSCR = 17408;
constexpr int MISC_OFF = 143360;
constexpr int LDS_BYTES = 147456;
typedef GAS unsigned gu32;
#define RLX_AGENT __ATOMIC_RELAXED, __HIP_MEMORY_SCOPE_AGENT

#define XB_TMO      128
#define XB_XCNT(j)  (256  + 64 * (j))
#define XB_XSUB(j)  (1280 + 64 * (j))
#define XB_XGEN(j)  (2304 + 64 * (j))
#define XB_TOP      3328
#define XB_TOPGEN   3392
#define XCD_BAR_WORDS 3456
#define XB_SPIN_CAP (1u << 22)
DI unsigned xb_ld(unsigned* p)              { return __hip_atomic_load(p, __ATOMIC_RELAXED, __HIP_MEMORY_SCOPE_AGENT); }
DI unsigned xb_add(unsigned* p, unsigned v) { return __hip_atomic_fetch_add(p, v, __ATOMIC_RELAXED, __HIP_MEMORY_SCOPE_AGENT); }
DI unsigned xb_xcc_id() { return (unsigned)__builtin_amdgcn_s_getreg((3 << 11) | 20) & 0xFu; }
#define XB_SPIN(cond, bar) do { unsigned _sp = 0; while (cond) { __builtin_amdgcn_s_sleep(1); \
    if ((++_sp & 255u) == 0u) { if (xb_ld(&(bar)[XB_TMO])) break; if (_sp > XB_SPIN_CAP) { atomicAdd(&(bar)[XB_TMO], 1u); break; } } } } while (0)
struct XcdBarrier { unsigned* bar; unsigned x; volatile LAS unsigned* st; };
DI XcdBarrier xcd_barrier_post(unsigned* bar, volatile LAS unsigned* st) {
    XcdBarrier b; b.bar = bar; b.x = xb_xcc_id(); b.st = st;
    if (threadIdx.x == 0) (void)xb_add(&bar[XB_XCNT(b.x)], 1u);
    return b;
}
DI void xcd_barrier_complete(unsigned* bar, unsigned x, unsigned& nloc, unsigned& nx) {
    const unsigned G = gridDim.x * gridDim.y * gridDim.z;
    unsigned sum, cnt, mine, sp = 0u;
    for (;;) {
        sum = 0u; cnt = 0u; mine = 0u;
#pragma unroll
        for (unsigned j = 0; j < 16; ++j) { const unsigned c = xb_ld(&bar[XB_XCNT(j)]); sum += c; cnt += (c > 0u) ? 1u : 0u; mine = (j == x) ? c : mine; }
        if (sum == G) break;
        __builtin_amdgcn_s_sleep(1);
        if ((++sp & 255u) == 0u) { if (xb_ld(&bar[XB_TMO])) break; if (sp > XB_SPIN_CAP) { atomicAdd(&bar[XB_TMO], 1u); break; } }
    }
    nloc = mine > 0u ? mine : 1u; nx = cnt > 0u ? cnt : 1u;
}
DI void xcd_barrier(const XcdBarrier& b) {
    asm volatile("s_waitcnt vmcnt(0)" ::: "memory");
    __syncthreads();
    if (threadIdx.x == 0) {
        unsigned* bar = b.bar;
        __builtin_amdgcn_s_waitcnt(0);
        unsigned nloc = b.st[0], nx = b.st[1];
        if (nloc == 0u) { xcd_barrier_complete(bar, b.x, nloc, nx); b.st[0] = nloc; b.st[1] = nx; }
        const unsigned old = xb_add(&bar[XB_XSUB(b.x)], 1u);
        const unsigned gen = old / nloc;
        if (old + 1u == (gen + 1u) * nloc) {
            __builtin_amdgcn_fence(__ATOMIC_RELEASE, "agent");
            asm volatile("s_waitcnt vmcnt(0)" ::: "memory");
            const unsigned og = xb_add(&bar[XB_TOP], 1u);
            const unsigned tg = og / nx;
            if (og + 1u == (tg + 1u) * nx) { xb_add(&bar[XB_TOPGEN], 1u); __builtin_amdgcn_fence(__ATOMIC_ACQUIRE, "agent"); }
            else { __builtin_amdgcn_fence(__ATOMIC_ACQUIRE, "agent"); XB_SPIN(xb_ld(&bar[XB_TOPGEN]) == tg, bar); }
            xb_add(&bar[XB_XGEN(b.x)], 1u);
            asm volatile("s_waitcnt vmcnt(0)" ::: "memory");
        } else {
            __builtin_amdgcn_fence(__ATOMIC_ACQUIRE, "agent");
            XB_SPIN(xb_ld(&bar[XB_XGEN(b.x)]) == gen, bar);
            asm volatile("s_waitcnt vmcnt(0)" ::: "memory");
        }
    }
    __syncthreads();
}

struct Args {
    const float* in[24]; float* out; unsigned char* ws;
    bf16_t *xb, *Wt_in, *Wt_out, *Wt_glu, *Wt_cin, *Wt_cgrp, *Wt_cout, *Wt_gu, *Wt_dn, *Wcin_b;
    bf16_t *Hb, *Vt, *Gs, *Ycat, *h1, *hid, *ffn, *h2, *Hc, *Pl, *Yg;
    bf16_t* Pre; float *states, *gates;
    int *cnt, *tok_list, *crow_list; unsigned* bar; unsigned* ready;
    int ph_lo, ph_hi, cmask, pad;
};
#define MFMA16(a, b, c) __builtin_amdgcn_mfma_f32_16x16x32_bf16((a), (b), (c), 0, 0, 0)
constexpr int S5_PITCH = 132;
DI bf16x8 pack8v(const f32x4 a, const f32x4 b) {
    u32x4 p; p.x = cvt_pk_bf16(a[0], a[1]); p.y = cvt_pk_bf16(a[2], a[3]); p.z = cvt_pk_bf16(b[0], b[1]); p.w = cvt_pk_bf16(b[2], b[3]);
    return __builtin_bit_cast(bf16x8, p);
}
template <int MODE>
DI void s5_task(const Args& a, LAS float* img, int b, int g, int span, int lane) {
    const float* lam_re = a.in[2]; const float* lam_im = a.in[3]; const float* log_dt = a.in[4];
    const float* b_re = a.in[5]; const float* b_im = a.in[6]; const float* c_re = a.in[7]; const float* c_im = a.in[8]; const float* dsk = a.in[9];
    const bf16_t* Hb = a.Hb;
    const float dt = expf(log_dt[g]);
    float lbr, lbi;
    { const float lr = lam_re[g * 64 + lane], li = lam_im[g * 64 + lane]; const float mag = expf(lr * dt); lbr = mag * cosf(li * dt); lbi = mag * sinf(li * dt); }
    const int hh = lane >> 5;
    bf16x8 bm[4];
#pragma unroll
    for (int half = 0; half < 2; ++half) {
        const int n = 32 * half + (lane & 31);
        const float lr = lam_re[g * 64 + n], li = lam_im[g * 64 + n]; const float mag = expf(lr * dt);
        const float er = mag * cosf(li * dt), ei = mag * sinf(li * dt); const float den = lr * lr + li * li;
        const float cfr = ((er - 1.f) * lr + ei * li) / den, cfi = (ei * lr - (er - 1.f) * li) / den;
        const float* brp = b_re + (size_t)(g * 64 + n) * 16 + 8 * hh; const float* bip = b_im + (size_t)(g * 64 + n) * 16 + 8 * hh;
        const f32x4 br0 = *(const f32x4*)brp, br1 = *(const f32x4*)(brp + 4), bi0 = *(const f32x4*)bip, bi1 = *(const f32x4*)(bip + 4);
        const f32x4 re0 = cfr * br0 - cfi * bi0, re1 = cfr * br1 - cfi * bi1, im0 = cfr * bi0 + cfi * br0, im1 = cfr * bi1 + cfi * br1;
        bm[half] = pack8v(re0, re1); bm[2 + half] = pack8v(im0, im1);
    }
    const int kq = lane >> 4, hcol = lane & 15;
    bf16x8 cm[4]; float dskv = 0.f;
    if (MODE == 1) {
#pragma unroll
        for (int ks = 0; ks < 4; ++ks) {
            const float* src = ((ks < 2) ? c_re : c_im) + (size_t)(g * 16 + hcol) * 64 + 32 * (ks & 1) + 8 * kq;
            f32x4 v0 = *(const f32x4*)src, v1 = *(const f32x4*)(src + 4);
            if (ks >= 2) { v0 = -v0; v1 = -v1; }
            cm[ks] = pack8v(v0, v1);
        }
        dskv = dsk[g * 16 + hcol];
    }
    float sre = 0.f, sim = 0.f;
    if (MODE == 1 && span > 0) {
        float pr = lbr, pi = lbi;
#pragma unroll
        for (int i = 0; i < 8; ++i) { const float nr = pr * pr - pi * pi, ni = 2.f * pr * pi; pr = nr; pi = ni; }
        const float* E = a.states + ((size_t)(b * 16) * 32 + g) * 128 + lane;
        float er[15], ei[15];
#pragma unroll
        for (int sp = 0; sp < 15; ++sp) { const bool on = sp < span; er[sp] = on ? E[(size_t)sp * 32 * 128] : 0.f; ei[sp] = on ? E[(size_t)sp * 32 * 128 + 64] : 0.f; }
#pragma unroll
        for (int sp = 0; sp < 15; ++sp) if (sp < span) {
            const float nr = pr * sre - pi * sim + er[sp], ni = pr * sim + pi * sre + ei[sp]; sre = nr; sim = ni;
        }
    }
    const int tok_base = b * 4096 + span * 256;
    for (int sub = 0; sub < 8; ++sub) {
        const int tok0 = tok_base + sub * 32;
        const bf16x8 uf = *(const bf16x8*)(Hb + (size_t)(tok0 + (lane & 31)) * 5120 + g * 16 + 8 * hh);
#pragma unroll
        for (int ct = 0; ct < 4; ++ct) {
            f32x16 d;
#pragma unroll
            for (int i = 0; i < 16; ++i) d[i] = 0.f;
            d = MFMA32(uf, bm[ct], d);
#pragma unroll
            for (int i = 0; i < 16; ++i) { const int t = (i & 3) + 8 * (i >> 2) + 4 * hh; img[t * S5_PITCH + 32 * ct + (lane & 31)] = d[i]; }
        }
        LDS_WAIT(); asm volatile("" ::: "memory");
#pragma unroll 8
        for (int t = 0; t < 32; ++t) {
            const float br = img[t * S5_PITCH + lane], bi = img[t * S5_PITCH + 64 + lane];
            const float nr = lbr * sre - lbi * sim + br, ni = lbr * sim + lbi * sre + bi; sre = nr; sim = ni;
            if (MODE == 1) { img[t * S5_PITCH + lane] = sre; img[t * S5_PITCH + 64 + lane] = sim; }
        }
        if (MODE == 1) {
            LDS_WAIT(); asm volatile("" ::: "memory");
#pragma unroll
            for (int tt = 0; tt < 2; ++tt) {
                f32x4 y = {0.f, 0.f, 0.f, 0.f};
#pragma unroll
                for (int ks = 0; ks < 4; ++ks) {
                    const LAS float* sp = img + (16 * tt + hcol) * S5_PITCH + 32 * ks + 8 * kq;
                    const f32x4 s0 = *(const LAS f32x4*)sp, s1 = *(const LAS f32x4*)(sp + 4);
                    y = MFMA16(pack8v(s0, s1), cm[ks], y);
                }
#pragma unroll
                for (int i = 0; i < 4; ++i) {
                    const size_t tok = (size_t)(tok0 + 16 * tt + 4 * kq + i);
                    const float uv = bf2f(Hb[tok * 5120 + g * 16 + hcol]);
                    const float v = y[i] + dskv * uv;
                    const float aa = 0.7978845608028654f * (v + 0.044715f * v * v * v);
                    const float gl = v * __builtin_amdgcn_rcpf(1.f + __expf(-2.f * aa));
                    a.Gs[tok * 512 + g * 16 + hcol] = (bf16_t)(cvt_pk_bf16(gl, 0.f) & 0xffffu);
                }
            }
            LDS_WAIT(); asm volatile("" ::: "memory");
        }
    }
    if (MODE == 0) { float* E = a.states + ((size_t)(b * 16 + span) * 32 + g) * 128 + lane; E[0] = sre; E[64] = sim; }
}

DI void s5_end_task(const Args& a, int b, int g, int span, int lane) {
    const float* lam_re = a.in[2]; const float* lam_im = a.in[3]; const float* log_dt = a.in[4];
    const float* b_re = a.in[5]; const float* b_im = a.in[6];
    const bf16_t* Hb = a.Hb;
    const float dt = expf(log_dt[g]);
    const int hh = lane >> 5;
    bf16x8 bm[4]; float lr[2], li[2], l4r[2], l4i[2];
#pragma unroll
    for (int half = 0; half < 2; ++half) {
        const int n = 32 * half + (lane & 31);
        const float lrn = lam_re[g * 64 + n], lin = lam_im[g * 64 + n]; const float mag = expf(lrn * dt);
        const float er = mag * cosf(lin * dt), ei = mag * sinf(lin * dt); const float den = lrn * lrn + lin * lin;
        const float cfr = ((er - 1.f) * lrn + ei * lin) / den, cfi = (ei * lrn - (er - 1.f) * lin) / den;
        const float* brp = b_re + (size_t)(g * 64 + n) * 16 + 8 * hh; const float* bip = b_im + (size_t)(g * 64 + n) * 16 + 8 * hh;
        const f32x4 br0 = *(const f32x4*)brp, br1 = *(const f32x4*)(brp + 4), bi0 = *(const f32x4*)bip, bi1 = *(const f32x4*)(bip + 4);
        const f32x4 re0 = cfr * br0 - cfi * bi0, re1 = cfr * br1 - cfi * bi1, im0 = cfr * bi0 + cfi * br0, im1 = cfr * bi1 + cfi * br1;
        bm[half] = pack8v(re0, re1); bm[2 + half] = pack8v(im0, im1);
        lr[half] = er; li[half] = ei;
        const float r2 = er * er - ei * ei, i2 = 2.f * er * ei; l4r[half] = r2 * r2 - i2 * i2; l4i[half] = 2.f * r2 * i2;
    }
    float sr[2] = {0.f, 0.f}, si[2] = {0.f, 0.f};
    const int tok_base = b * 4096 + span * 256;
    bf16x8 ufa[8];
#pragma unroll
    for (int sub = 0; sub < 8; ++sub) ufa[sub] = *(const bf16x8*)(Hb + (size_t)(tok_base + sub * 32 + (lane & 31)) * 5120 + g * 16 + 8 * hh);
#pragma unroll
    for (int sub = 0; sub < 8; ++sub) {
        const bf16x8 uf = ufa[sub];
        f32x16 d[4];
#pragma unroll
        for (int ct = 0; ct < 4; ++ct) {
#pragma unroll
            for (int i = 0; i < 16; ++i) d[ct][i] = 0.f;
            d[ct] = MFMA32(uf, bm[ct], d[ct]);
        }
#pragma unroll
        for (int s = 0; s < 2; ++s) {
            float Er[8], Ei[8];
#pragma unroll
            for (int q = 0; q < 4; ++q) {
                float er = d[s][4 * q], ei = d[2 + s][4 * q];
#pragma unroll
                for (int j = 1; j < 4; ++j) { const float nr = lr[s] * er - li[s] * ei + d[s][4 * q + j], ni = lr[s] * ei + li[s] * er + d[2 + s][4 * q + j]; er = nr; ei = ni; }
                const unsigned ur = __builtin_bit_cast(unsigned, er), ui = __builtin_bit_cast(unsigned, ei);
                const auto xr = __builtin_amdgcn_permlane32_swap(ur, ur, false, false), xi = __builtin_amdgcn_permlane32_swap(ui, ui, false, false);
                Er[2 * q] = __builtin_bit_cast(float, xr[0]); Er[2 * q + 1] = __builtin_bit_cast(float, xr[1]);
                Ei[2 * q] = __builtin_bit_cast(float, xi[0]); Ei[2 * q + 1] = __builtin_bit_cast(float, xi[1]);
            }
#pragma unroll
            for (int blk = 0; blk < 8; ++blk) { const float nr = l4r[s] * sr[s] - l4i[s] * si[s] + Er[blk], ni = l4r[s] * si[s] + l4i[s] * sr[s] + Ei[blk]; sr[s] = nr; si[s] = ni; }
        }
    }
    float* E = a.states + ((size_t)(b * 16 + span) * 32 + g) * 128 + lane;
    E[0] = hh ? sr[1] : sr[0]; E[64] = hh ? si[1] : si[0];
}

DI void s5_out_task(const Args& a, LAS float* img, int b, int g, int span, int lane) {
    const float* lam_re = a.in[2]; const float* lam_im = a.in[3]; const float* log_dt = a.in[4];
    const float* b_re = a.in[5]; const float* b_im = a.in[6]; const float* c_re = a.in[7]; const float* c_im = a.in[8]; const float* dsk = a.in[9];
    const bf16_t* Hb = a.Hb;
    const float dt = expf(log_dt[g]);
    const int hh = lane >> 5, c = lane & 31;
    const int tok_base = b * 4096 + span * 256;
    bf16x8 ufa[8];
#pragma unroll
    for (int sub = 0; sub < 8; ++sub) ufa[sub] = *(const bf16x8*)(Hb + (size_t)(tok_base + sub * 32 + c) * 5120 + g * 16 + 8 * hh);
    float lbr, lbi;
    { const float lr = lam_re[g * 64 + lane], li = lam_im[g * 64 + lane]; const float mag = expf(lr * dt); lbr = mag * cosf(li * dt); lbi = mag * sinf(li * dt); }
    bf16x8 bm[4]; float pwr[2][4], pwi[2][4];
#pragma unroll
    for (int half = 0; half < 2; ++half) {
        const int n = 32 * half + c;
        const float lrn = lam_re[g * 64 + n], lin = lam_im[g * 64 + n]; const float mag = expf(lrn * dt);
        const float er = mag * cosf(lin * dt), ei = mag * sinf(lin * dt); const float den = lrn * lrn + lin * lin;
        const float cfr = ((er - 1.f) * lrn + ei * lin) / den, cfi = (ei * lrn - (er - 1.f) * lin) / den;
        const float* brp = b_re + (size_t)(g * 64 + n) * 16 + 8 * hh; const float* bip = b_im + (size_t)(g * 64 + n) * 16 + 8 * hh;
        const f32x4 br0 = *(const f32x4*)brp, br1 = *(const f32x4*)(brp + 4), bi0 = *(const f32x4*)bip, bi1 = *(const f32x4*)(bip + 4);
        const f32x4 re0 = cfr * br0 - cfi * bi0, re1 = cfr * br1 - cfi * bi1, im0 = cfr * bi0 + cfi * br0, im1 = cfr * bi1 + cfi * br1;
        bm[half] = pack8v(re0, re1); bm[2 + half] = pack8v(im0, im1);
        pwr[half][0] = er; pwi[half][0] = ei;
#pragma unroll
        for (int k = 1; k < 4; ++k) { pwr[half][k] = pwr[half][k - 1] * er - pwi[half][k - 1] * ei; pwi[half][k] = pwr[half][k - 1] * ei + pwi[half][k - 1] * er; }
    }
    const int kq = lane >> 4, hcol = lane & 15;
    bf16x8 cm[5];
#pragma unroll
    for (int ks = 0; ks < 4; ++ks) {
        const float* src = ((ks < 2) ? c_re : c_im) + (size_t)(g * 16 + hcol) * 64 + 32 * (ks & 1) + 8 * kq;
        f32x4 v0 = *(const f32x4*)src, v1 = *(const f32x4*)(src + 4);
        if (ks >= 2) { v0 = -v0; v1 = -v1; }
        cm[ks] = pack8v(v0, v1);
    }
    { const float dfull = dsk[g * 16 + hcol]; const float dhi = bflo(cvt_pk_bf16(dfull, 0.f) & 0xffffu); const float dv = (kq < 2) ? dhi : (dfull - dhi);
      f32x4 v0 = {0.f, 0.f, 0.f, 0.f}, v1 = {0.f, 0.f, 0.f, 0.f};
#pragma unroll
      for (int j = 0; j < 4; ++j) { v0[j] = (8 * (kq & 1) + j == hcol) ? dv : 0.f; v1[j] = (8 * (kq & 1) + 4 + j == hcol) ? dv : 0.f; }
      cm[4] = pack8v(v0, v1); }
    float sre = 0.f, sim = 0.f;
    if (span > 0) {
        float pr = lbr, pi = lbi;
#pragma unroll
        for (int i = 0; i < 8; ++i) { const float nr = pr * pr - pi * pi, ni = 2.f * pr * pi; pr = nr; pi = ni; }
        const float* E = a.states + ((size_t)(b * 16) * 32 + g) * 128 + lane;
        float er[15], ei[15];
#pragma unroll
        for (int sp = 0; sp < 15; ++sp) { const bool on = sp < span; er[sp] = on ? E[(size_t)sp * 32 * 128] : 0.f; ei[sp] = on ? E[(size_t)sp * 32 * 128 + 64] : 0.f; }
#pragma unroll
        for (int sp = 0; sp < 15; ++sp) if (sp < span) { const float nr = pr * sre - pi * sim + er[sp], ni = pr * sim + pi * sre + ei[sp]; sre = nr; sim = ni; }
    }
    float sr[2], si[2];
    { const unsigned ur = __builtin_bit_cast(unsigned, sre), ui = __builtin_bit_cast(unsigned, sim);
      const auto xr = __builtin_amdgcn_permlane32_swap(ur, ur, false, false), xi = __builtin_amdgcn_permlane32_swap(ui, ui, false, false);
      sr[0] = __builtin_bit_cast(float, xr[0]); sr[1] = __builtin_bit_cast(float, xr[1]); si[0] = __builtin_bit_cast(float, xi[0]); si[1] = __builtin_bit_cast(float, xi[1]); }
    const int bp0 = (32 * (kq & 1) + hcol) * 4;
#pragma nounroll
    for (int sub = 0; sub < 8; ++sub) {
        const int tok0 = tok_base + sub * 32;
        const bf16x8 ucur = ufa[0];
#pragma unroll
        for (int i = 0; i < 7; ++i) ufa[i] = ufa[i + 1];
        f32x16 d[4];
#pragma unroll
        for (int ct = 0; ct < 4; ++ct) {
#pragma unroll
            for (int i = 0; i < 16; ++i) d[ct][i] = 0.f;
            d[ct] = MFMA32(ucur, bm[ct], d[ct]);
        }
#pragma unroll
        for (int s = 0; s < 2; ++s) {
            float Er[8], Ei[8];
#pragma unroll
            for (int q = 0; q < 4; ++q) {
#pragma unroll
                for (int j = 1; j < 4; ++j) { const float pr_ = d[s][4 * q + j - 1], pi_ = d[2 + s][4 * q + j - 1];
                    d[s][4 * q + j] += pwr[s][0] * pr_ - pwi[s][0] * pi_; d[2 + s][4 * q + j] += pwr[s][0] * pi_ + pwi[s][0] * pr_; }
                const unsigned ur = __builtin_bit_cast(unsigned, d[s][4 * q + 3]), ui = __builtin_bit_cast(unsigned, d[2 + s][4 * q + 3]);
                const auto xr = __builtin_amdgcn_permlane32_swap(ur, ur, false, false), xi = __builtin_amdgcn_permlane32_swap(ui, ui, false, false);
                Er[2 * q] = __builtin_bit_cast(float, xr[0]); Er[2 * q + 1] = __builtin_bit_cast(float, xr[1]);
                Ei[2 * q] = __builtin_bit_cast(float, xi[0]); Ei[2 * q + 1] = __builtin_bit_cast(float, xi[1]);
            }
            float cr = sr[s], ci = si[s];
#pragma unroll
            for (int q = 0; q < 4; ++q) {
                const float c1r = pwr[s][3] * cr - pwi[s][3] * ci + Er[2 * q], c1i = pwr[s][3] * ci + pwi[s][3] * cr + Ei[2 * q];
                const float owr = hh ? c1r : cr, owi = hh ? c1i : ci;
#pragma unroll
                for (int j = 0; j < 4; ++j) { d[s][4 * q + j] += pwr[s][j] * owr - pwi[s][j] * owi; d[2 + s][4 * q + j] += pwr[s][j] * owi + pwi[s][j] * owr; }
                cr = pwr[s][3] * c1r - pwi[s][3] * c1i + Er[2 * q + 1]; ci = pwr[s][3] * c1i + pwi[s][3] * c1r + Ei[2 * q + 1];
            }
            sr[s] = cr; si[s] = ci;
#pragma unroll
            for (int q = 0; q < 4; ++q)
#pragma unroll
                for (int j = 0; j < 4; ++j) { const int t = 8 * q + 4 * hh + j; img[t * S5_PITCH + 32 * s + c] = d[s][4 * q + j]; img[t * S5_PITCH + 64 + 32 * s + c] = d[2 + s][4 * q + j]; }
        }
        bf16x8 ua[2];
        { const u32x4 uw = __builtin_bit_cast(u32x4, ucur);
#pragma unroll
          for (int tt = 0; tt < 2; ++tt) { u32x4 r;
              r.x = (unsigned)__builtin_amdgcn_ds_bpermute(bp0 + 64 * tt, (int)uw.x); r.y = (unsigned)__builtin_amdgcn_ds_bpermute(bp0 + 64 * tt, (int)uw.y);
              r.z = (unsigned)__builtin_amdgcn_ds_bpermute(bp0 + 64 * tt, (int)uw.z); r.w = (unsigned)__builtin_amdgcn_ds_bpermute(bp0 + 64 * tt, (int)uw.w);
              ua[tt] = __builtin_bit_cast(bf16x8, r); } }
        LDS_WAIT(); asm volatile("" ::: "memory");
#pragma unroll
        for (int tt = 0; tt < 2; ++tt) {
            f32x4 y = {0.f, 0.f, 0.f, 0.f};
#pragma unroll
            for (int ks = 0; ks < 4; ++ks) {
                const LAS float* sp = img + (16 * tt + hcol) * S5_PITCH + 32 * ks + 8 * kq;
                const f32x4 s0 = *(const LAS f32x4*)sp, s1 = *(const LAS f32x4*)(sp + 4);
                y = MFMA16(pack8v(s0, s1), cm[ks], y);
            }
            y = MFMA16(ua[tt], cm[4], y);
#pragma unroll
            for (int i = 0; i < 4; ++i) {
                const size_t tok = (size_t)(tok0 + 16 * tt + 4 * kq + i);
                const float v = y[i];
                const float aa = 0.7978845608028654f * (v + 0.044715f * v * v * v);
                const float gl = v * __builtin_amdgcn_rcpf(1.f + __expf(-2.f * aa));
                a.Gs[tok * 512 + g * 16 + hcol] = (bf16_t)(cvt_pk_bf16(gl, 0.f) & 0xffffu);
            }
        }
        LDS_WAIT(); asm volatile("" ::: "memory");
    }
}

struct Frame { LAS unsigned char* lds; volatile LAS unsigned* MISC; int tid, lane, wave, G, gw, NGW; };

DI float wave_sum(float v) {
#pragma unroll
    for (int o = 1; o < 64; o <<= 1) v += __shfl_xor(v, o);
    return v;
}

constexpr float ALPHA_F = 1.41421356237309515f, LN_EPS_F = 1e-5f;
DI void ln_stats32(float (&v)[32], float& mean, float& rstd) {
    float s = 0.f;
#pragma unroll
    for (int i = 0; i < 32; i += 4) s += (v[i] + v[i + 1]) + (v[i + 2] + v[i + 3]);
    mean = wave_sum(s) * (1.f / 2048.f);
    float q = 0.f;
#pragma unroll
    for (int i = 0; i < 32; i += 4) { v[i] -= mean; v[i + 1] -= mean; v[i + 2] -= mean; v[i + 3] -= mean; q += (v[i] * v[i] + v[i + 1] * v[i + 1]) + (v[i + 2] * v[i + 2] + v[i + 3] * v[i + 3]); }
    rstd = 1.f / sqrtf(wave_sum(q) * (1.f / 2048.f) + LN_EPS_F);
}
DI void up8a(const u32x4 x, float* f) { f[0] = bflo(x.x); f[1] = bfhi(x.x); f[2] = bflo(x.y); f[3] = bfhi(x.y); f[4] = bflo(x.z); f[5] = bfhi(x.z); f[6] = bflo(x.w); f[7] = bfhi(x.w); }

struct Ln1Row { u32x4 pre[4]; };
DI void ln1_load(Ln1Row& R, const bf16_t* Pre, size_t row, int lane) {
#pragma unroll
    for (int j = 0; j < 4; ++j) R.pre[j] = *(const u32x4*)(Pre + row * 2048 + 512 * j + 8 * lane);
}
constexpr int LN1_LOGIT_OFF = 131072;
DI void ln1_router_phase(const Frame& F, const bf16_t* Pre, const float* lg, const float* lb, const float* rw, const float* rb,
                         bf16_t* h1, float* gates, int* cnt, int* tok_list, int* crow_list) {
    LAS f32x4* W4 = (LAS f32x4*)F.lds;
    for (int idx = F.tid; idx < 8192; idx += NWAVES * 64) { const int c = idx >> 2, e4 = idx & 3;
        W4[(e4 * 8 + (c & 7)) * 256 + (c >> 3)] = *(const f32x4*)(rw + (size_t)c * 16 + e4 * 4); }
    LAS float* LT = (LAS float*)(F.lds + LN1_LOGIT_OFF);
    volatile LAS int* lcnt = (volatile LAS int*)(F.MISC + 64); volatile LAS int* lbase = (volatile LAS int*)(F.MISC + 80);
    for (int rb0 = blockIdx.x * 64; rb0 < 16384; rb0 += F.G * 64) {
        if (F.tid < 16) lcnt[F.tid] = 0;
        __syncthreads();
        Ln1Row nx; ln1_load(nx, Pre, (size_t)(rb0 + F.wave * 8), F.lane);
        for (int i = 0; i < 8; ++i) {
            const int lr = F.wave * 8 + i; const size_t row = (size_t)(rb0 + lr);
            float v[32];
#pragma unroll
            for (int j = 0; j < 4; ++j) up8a(nx.pre[j], &v[8 * j]);
            if (i < 7) ln1_load(nx, Pre, row + 1, F.lane);
            float mean, rstd; ln_stats32(v, mean, rstd);
            f32x2 lg2[8];
#pragma unroll
            for (int e = 0; e < 8; ++e) lg2[e] = (f32x2){0.f, 0.f};
#pragma unroll
            for (int j = 0; j < 4; ++j) {
                const int cb = 512 * j + 8 * F.lane;
                const f32x4 ga = *(const f32x4*)(lg + cb), gb = *(const f32x4*)(lg + cb + 4), ba = *(const f32x4*)(lb + cb), bb = *(const f32x4*)(lb + cb + 4);
#pragma unroll
                for (int q = 0; q < 4; ++q) { v[8 * j + q] = v[8 * j + q] * rstd * ga[q] + ba[q]; v[8 * j + 4 + q] = v[8 * j + 4 + q] * rstd * gb[q] + bb[q]; }
                u32x4 w; w.x = cvt_pk_bf16(v[8 * j], v[8 * j + 1]); w.y = cvt_pk_bf16(v[8 * j + 2], v[8 * j + 3]); w.z = cvt_pk_bf16(v[8 * j + 4], v[8 * j + 5]); w.w = cvt_pk_bf16(v[8 * j + 6], v[8 * j + 7]);
                *(u32x4*)(h1 + row * 2048 + cb) = w;
#pragma unroll
                for (int q = 0; q < 8; ++q) {
#pragma unroll
                    for (int e4 = 0; e4 < 4; ++e4) { const f32x4 wv = W4[(e4 * 8 + q) * 256 + 64 * j + F.lane]; const f32x2 x2 = {v[8 * j + q], v[8 * j + q]};
                        lg2[2 * e4] = __builtin_elementwise_fma(x2, (f32x2){wv[0], wv[1]}, lg2[2 * e4]); lg2[2 * e4 + 1] = __builtin_elementwise_fma(x2, (f32x2){wv[2], wv[3]}, lg2[2 * e4 + 1]); }
                    if (q & 1) __builtin_amdgcn_sched_barrier(0);
                }
            }
            {
                float lgt[16];
#pragma unroll
                for (int e = 0; e < 8; ++e) { lgt[2 * e] = lg2[e][0]; lgt[2 * e + 1] = lg2[e][1]; }
                const bool up = (F.lane & 32) != 0;
#pragma unroll
                for (int e = 0; e < 8; ++e) { const float keep = up ? lgt[e + 8] : lgt[e], send = up ? lgt[e] : lgt[e + 8]; lgt[e] = keep + __shfl_xor(send, 32); }
                const bool u16 = (F.lane & 16) != 0;
#pragma unroll
                for (int e = 0; e < 4; ++e) { const float keep = u16 ? lgt[e + 4] : lgt[e], send = u16 ? lgt[e] : lgt[e + 4]; lgt[e] = keep + __shfl_xor(send, 16); }
                const bool u8 = (F.lane & 8) != 0;
#pragma unroll
                for (int e = 0; e < 2; ++e) { const float keep = u8 ? lgt[e + 2] : lgt[e], send = u8 ? lgt[e] : lgt[e + 2]; lgt[e] = keep + __shfl_xor(send, 8); }
                const bool u4 = (F.lane & 4) != 0;
                { const float keep = u4 ? lgt[1] : lgt[0], send = u4 ? lgt[0] : lgt[1]; lgt[0] = keep + __shfl_xor(send, 4); }
                lgt[0] += __shfl_xor(lgt[0], 2); lgt[0] += __shfl_xor(lgt[0], 1);
                const int ex = ((F.lane >> 5) & 1) * 8 + ((F.lane >> 4) & 1) * 4 + ((F.lane >> 3) & 1) * 2 + ((F.lane >> 2) & 1);
                if ((F.lane & 3) == 0) LT[lr * 16 + ex] = lgt[0] + rb[ex];
            }
        }
        __syncthreads();
        if (F.wave == 0) {
            const int lr = F.lane; const size_t row = (size_t)(rb0 + lr);
            float p[16];
#pragma unroll
            for (int e4 = 0; e4 < 4; ++e4) { const f32x4 t = *(const LAS f32x4*)(LT + lr * 16 + 4 * e4); p[4 * e4] = t[0]; p[4 * e4 + 1] = t[1]; p[4 * e4 + 2] = t[2]; p[4 * e4 + 3] = t[3]; }
            float mx = p[0];
#pragma unroll
            for (int e = 1; e < 16; ++e) mx = fmaxf(mx, p[e]);
#pragma unroll
            for (int e = 0; e < 16; ++e) p[e] = expf(p[e] - mx);
            int gsel = 0; float best = -1.f;
#pragma unroll
            for (int gi = 0; gi < 4; ++gi) {
                float m1 = -1.f, m2 = -1.f;
#pragma unroll
                for (int jj = 0; jj < 4; ++jj) { const float pv = p[gi * 4 + jj]; if (pv > m1) { m2 = m1; m1 = pv; } else if (pv > m2) m2 = pv; }
                const float sc = m1 + m2;
                if (sc > best) { best = sc; gsel = gi; }
            }
            int i1 = 0, i2 = 0; float m1 = -1.f, m2 = -1.f;
#pragma unroll
            for (int e = 0; e < 16; ++e) if ((e >> 2) == gsel) { const float pv = p[e]; if (pv > m1) { m2 = m1; i2 = i1; m1 = pv; i1 = e; } else if (pv > m2) { m2 = pv; i2 = e; } }
            const float den = m1 + m2;
            gates[2 * row] = m1 / den; gates[2 * row + 1] = m2 / den;
            const int s1 = __hip_atomic_fetch_add((LAS int*)&lcnt[i1], 1, __ATOMIC_RELAXED, __HIP_MEMORY_SCOPE_WORKGROUP);
            const int s2 = __hip_atomic_fetch_add((LAS int*)&lcnt[i2], 1, __ATOMIC_RELAXED, __HIP_MEMORY_SCOPE_WORKGROUP);
            LDS_WAIT(); asm volatile("" ::: "memory");
            if (F.lane < 16) lbase[F.lane] = atomicAdd(&cnt[F.lane], lcnt[F.lane]);
            LDS_WAIT(); asm volatile("" ::: "memory");
            const int tok = rb0 + lr;
            const int d1 = lbase[i1] + s1, d2 = lbase[i2] + s2;
            tok_list[i1 * 16384 + d1] = tok; crow_list[i1 * 16384 + d1] = tok;
            tok_list[i2 * 16384 + d2] = tok; crow_list[i2 * 16384 + d2] = 16384 + tok;
        }
        __syncthreads();
    }
}

struct Ln2Row { u32x4 h[4], a[4], b[4]; float g0, g1; };
DI void ln2_load(Ln2Row& R, const bf16_t* h1, const bf16_t* ffn, const float* gates, size_t row, int lane) {
#pragma unroll
    for (int j = 0; j < 4; ++j) { const size_t o = row * 2048 + 512 * j + 8 * lane;
        R.h[j] = *(const u32x4*)(h1 + o); R.a[j] = *(const u32x4*)(ffn + o); R.b[j] = *(const u32x4*)(ffn + (size_t)16384 * 2048 + o); }
    R.g0 = gates[2 * row]; R.g1 = gates[2 * row + 1];
}
template <bool OUT_F32>
DI void ln2_phase(const Frame& F, const bf16_t* h1, const bf16_t* ffn, const float* gates, const float* lg, const float* lb, void* outp) {
    f32x4 gv[8], bv[8];
#pragma unroll
    for (int j = 0; j < 4; ++j) { const int cb = 512 * j + 8 * F.lane; gv[2 * j] = *(const f32x4*)(lg + cb); gv[2 * j + 1] = *(const f32x4*)(lg + cb + 4); bv[2 * j] = *(const f32x4*)(lb + cb); bv[2 * j + 1] = *(const f32x4*)(lb + cb + 4); }
    Ln2Row nx; ln2_load(nx, h1, ffn, gates, (size_t)F.gw, F.lane);
    for (int r = F.gw; r < 16384; r += F.NGW) {
        const size_t row = (size_t)r;
        float v[32];
#pragma unroll
        for (int j = 0; j < 4; ++j) { float x[8], y[8], z[8]; up8a(nx.h[j], x); up8a(nx.a[j], y); up8a(nx.b[j], z);
#pragma unroll
            for (int q = 0; q < 8; ++q) v[8 * j + q] = ALPHA_F * x[q] + nx.g0 * y[q] + nx.g1 * z[q]; }
        if (r + F.NGW < 16384) ln2_load(nx, h1, ffn, gates, (size_t)(r + F.NGW), F.lane);
        float mean, rstd; ln_stats32(v, mean, rstd);
#pragma unroll
        for (int j = 0; j < 4; ++j) {
#pragma unroll
            for (int q = 0; q < 4; ++q) { v[8 * j + q] = v[8 * j + q] * rstd * gv[2 * j][q] + bv[2 * j][q]; v[8 * j + 4 + q] = v[8 * j + 4 + q] * rstd * gv[2 * j + 1][q] + bv[2 * j + 1][q]; }
            const size_t o = row * 2048 + 512 * j + 8 * F.lane;
            if (OUT_F32) { *(f32x4*)((float*)outp + o) = (f32x4){v[8 * j], v[8 * j + 1], v[8 * j + 2], v[8 * j + 3]}; *(f32x4*)((float*)outp + o + 4) = (f32x4){v[8 * j + 4], v[8 * j + 5], v[8 * j + 6], v[8 * j + 7]}; }
            else { u32x4 w; w.x = cvt_pk_bf16(v[8 * j], v[8 * j + 1]); w.y = cvt_pk_bf16(v[8 * j + 2], v[8 * j + 3]); w.z = cvt_pk_bf16(v[8 * j + 4], v[8 * j + 5]); w.w = cvt_pk_bf16(v[8 * j + 6], v[8 * j + 7]);
                *(u32x4*)((bf16_t*)outp + o) = w; }
        }
    }
}

DI void up8(const u32x4 x, float (&f)[8]) { f[0] = bflo(x.x); f[1] = bfhi(x.x); f[2] = bflo(x.y); f[3] = bfhi(x.y); f[4] = bflo(x.z); f[5] = bfhi(x.z); f[6] = bflo(x.w); f[7] = bfhi(x.w); }
template <int W> DI void pool_load(const bf16_t* __restrict__ Hc, size_t rowbase, int t0, int col, u32x4 (&x)[W + 7]) {
#pragma unroll
    for (int q = 0; q < W + 7; ++q) { const int t = t0 - (W - 1) + q;
        x[q] = (t >= 0) ? *(const u32x4*)(Hc + (rowbase + (size_t)(t >= 0 ? t : 0)) * 2048 + col) : (u32x4){0u, 0u, 0u, 0u}; }
}
template <int W> DI void pool_store(bf16_t* __restrict__ Pl, size_t rowbase, int t0, int col, const u32x4 (&x)[W + 7]) {
    float s[8];
#pragma unroll
    for (int c = 0; c < 8; ++c) s[c] = 0.f;
#pragma unroll
    for (int q = 0; q < W; ++q) { float f[8]; up8(x[q], f);
#pragma unroll
        for (int c = 0; c < 8; ++c) s[c] += f[c]; }
#pragma unroll
    for (int i = 0; i < 8; ++i) {
        const int t = t0 + i; const float inv = 1.f / (float)((t + 1) < W ? (t + 1) : W);
        float f[8]; up8(x[W - 1 + i], f);
        u32x4 o; o.x = cvt_pk_bf16(s[0] * inv - f[0], s[1] * inv - f[1]); o.y = cvt_pk_bf16(s[2] * inv - f[2], s[3] * inv - f[3]);
        o.z = cvt_pk_bf16(s[4] * inv - f[4], s[5] * inv - f[5]); o.w = cvt_pk_bf16(s[6] * inv - f[6], s[7] * inv - f[7]);
        *(u32x4*)(Pl + (rowbase + (size_t)t) * 2048 + col) = o;
        if (i < 7) { float a[8], d[8]; up8(x[W + i], a); up8(x[i], d);
#pragma unroll
            for (int c = 0; c < 8; ++c) s[c] += a[c] - d[c]; }
    }
}
DI void pool_phase(const Frame& F, const bf16_t* __restrict__ Hc, bf16_t* __restrict__ Pl) {
    for (int tb = F.gw; tb < 2048; tb += F.NGW) {
        const int tok0 = tb * 8; const size_t rowbase = (size_t)(tok0 & ~4095); const int t0 = tok0 & 4095; const int col = 8 * F.lane;
        { u32x4 xa[2 + 7], xb[4 + 7]; pool_load<2>(Hc, rowbase, t0, col, xa); pool_load<4>(Hc, rowbase, t0, 512 + col, xb);
          pool_store<2>(Pl, rowbase, t0, col, xa); pool_store<4>(Pl, rowbase, t0, 512 + col, xb); }
        { u32x4 xc[8 + 7], xd[16 + 7]; pool_load<8>(Hc, rowbase, t0, 1024 + col, xc); pool_load<16>(Hc, rowbase, t0, 1536 + col, xd);
          pool_store<8>(Pl, rowbase, t0, 1024 + col, xc); pool_store<16>(Pl, rowbase, t0, 1536 + col, xd); }
    }
}

constexpr int MOE0_QA = 8000, MOE0_QP4 = 8000;
struct ConvItem { const float* src; bf16_t* dst; int N, K, il, nb; };
DI void conv_load(const ConvItem& c, f32x4 (&t)[16]) {
#pragma unroll
    for (int p = 0; p < 16; ++p) t[p] = *(const f32x4*)(c.src + (size_t)(4 * p) * c.N);
}
DI void conv_store(const ConvItem& c, const f32x4 (&t)[16], LAS float* scr, int lane) {
    const int c4 = lane & 15;
#pragma unroll
    for (int p = 0; p < 16; ++p) { const int kk = 4 * p + (lane >> 4); *(LAS f32x4*)(scr + kk * 68 + ((4 * c4) ^ (((kk >> 3) & 7) << 2))) = t[p]; }
    LDS_WAIT(); asm volatile("" ::: "memory");
    const int c8 = lane & 7;
#pragma unroll
    for (int pp = 0; pp < 8; ++pp) { const int n = 8 * pp + (lane >> 3); const LAS float* s = scr + (8 * c8) * 68 + (n ^ (c8 << 2));
        u32x4 o; o.x = pk2(s[0 * 68], s[1 * 68]); o.y = pk2(s[2 * 68], s[3 * 68]); o.z = pk2(s[4 * 68], s[5 * 68]); o.w = pk2(s[6 * 68], s[7 * 68]);
        const int j = 64 * c.nb + n; const int drow = c.il ? ((j >> 4) * 32 + (c.il - 1) * 16 + (j & 15)) : j;
        *(u32x4*)(c.dst + (size_t)drow * c.K + 8 * c8) = o; }
    LDS_WAIT(); asm volatile("" ::: "memory");
}
DI ConvItem conv_item(const float* W0, const float* W1, int N, int K, bf16_t* WT, int il, int kb, int nb, int lane) {
    const int c4 = lane & 15; ConvItem c;
    c.src = ((il == 2 ? W1 : W0) + 64 * nb + 4 * c4) + (size_t)(64 * kb + (lane >> 4)) * N;
    c.dst = WT + 64 * kb; c.N = N; c.K = K; c.il = il; c.nb = nb; return c;
}
DI ConvItem moe_item(const Args& a, int l, int it, int lane) {
    if (it < 16384) { const int e = it >> 10, r = it & 1023; const size_t so = ((size_t)l * 16 + e) * 2048 * 1024;
        return conv_item(a.in[21] + so, a.in[22] + so, 1024, 2048, a.Wt_gu + ((size_t)l * 16 + e) * 2048 * 2048, 1 + ((r >> 4) & 1), r >> 5, r & 15, lane); }
    const int i2 = it - 16384, e = i2 >> 9, r = i2 & 511; const size_t so = ((size_t)l * 16 + e) * 1024 * 2048;
    return conv_item(a.in[23] + so, nullptr, 2048, 1024, a.Wt_dn + ((size_t)l * 16 + e) * 2048 * 1024, 0, r >> 5, r & 31, lane);
}
DI void moe_convert_range(const Frame& F, const Args& a, int l, int lo, int hi, int widx, int nw) {
    LAS float* scr = (LAS float*)(F.lds + F.wave * WSCR);
    int it = lo + widx; if (it >= hi) return;
    ConvItem cur = moe_item(a, l, it, F.lane); f32x4 t[16]; conv_load(cur, t);
    for (;;) {
        const int nx = it + nw; const bool more = nx < hi;
        ConvItem nxt = cur; f32x4 tn[16];
        if (more) { nxt = moe_item(a, l, nx, F.lane); conv_load(nxt, tn); }
        conv_store(cur, t, scr, F.lane);
        if (!more) break;
#pragma unroll
        for (int p = 0; p < 16; ++p) t[p] = tn[p];
        cur = nxt; it = nx;
    }
}
DI void conv_plain(const Frame& F, const float* W, int K, int N, bf16_t* WT, int widx = -1, int nw = 0) {
    LAS float* scr = (LAS float*)(F.lds + F.wave * WSCR);
    const int nnb = N / 64, nit = (K / 64) * nnb;
    if (widx < 0) { widx = F.gw; nw = F.NGW; }
    for (int it = widx; it < nit; it += nw) { const ConvItem c = conv_item(W, nullptr, N, K, WT, 0, it / nnb, it % nnb, F.lane); f32x4 t[16]; conv_load(c, t); conv_store(c, t, scr, F.lane); }
}
DI void p0_convert(const Frame& F, const Args& a) {
    const int m = a.cmask;
    if (m & 1) {
        const size_t n8 = (size_t)16384 * 2048 / 8, stride = (size_t)F.NGW * 64;
        for (size_t i = (size_t)F.gw * 64 + F.lane; i < n8; i += 4 * stride) {
            f32x4 v[4][2];
#pragma unroll
            for (int u = 0; u < 4; ++u) { const size_t j = i + u * stride; if (j < n8) { v[u][0] = *(const f32x4*)(a.in[0] + j * 8); v[u][1] = *(const f32x4*)(a.in[0] + j * 8 + 4); } }
#pragma unroll
            for (int u = 0; u < 4; ++u) { const size_t j = i + u * stride; if (j < n8) {
                u32x4 o; o.x = pk2(v[u][0][0], v[u][0][1]); o.y = pk2(v[u][0][2], v[u][0][3]); o.z = pk2(v[u][1][0], v[u][1][1]); o.w = pk2(v[u][1][2], v[u][1][3]);
                *(u32x4*)(a.xb + j * 8) = o; } }
        }
    }
    if (m & 2) conv_plain(F, a.in[1], 2048, 5120, a.Wt_in);
    if (m & 4) { if (!(m & 256)) conv_plain(F, a.in[12], 2048, 2048, a.Wt_out); conv_plain(F, a.in[10], 512, 512, a.Wt_glu); }
    if (m & 8) { if (!(m & 256)) conv_plain(F, a.in[16], 2048, 2048, a.Wt_cout);
        for (size_t i = (size_t)F.gw * 64 + F.lane; i < (size_t)2048 * 2048 / 8; i += (size_t)F.NGW * 64) {
            const f32x4 v0 = *(const f32x4*)(a.in[13] + i * 8), v1 = *(const f32x4*)(a.in[13] + i * 8 + 4);
            u32x4 o; o.x = pk2(v0[0], v0[1]); o.y = pk2(v0[2], v0[3]); o.z = pk2(v1[0], v1[1]); o.w = pk2(v1[2], v1[3]);
            *(u32x4*)(a.Wcin_b + i * 8) = o; }
        for (int g = 0; g < 4; ++g) conv_plain(F, a.in[14] + (size_t)g * 512 * 512, 512, 512, a.Wt_cgrp + (size_t)g * 512 * 512); }
    if (m & 16) moe_convert_range(F, a, 0, 0, (m & 128) ? ((m & 256) ? MOE0_QP4 : MOE0_QA) : 24576, F.gw, F.NGW);
    if (m & 32) moe_convert_range(F, a, 1, 0, 24576, F.gw, F.NGW);
}

DI void moe1_convert_range(const Frame& F, const Args& a, int lo, int hi, int widx, int nw) { moe_convert_range(F, a, 1, lo, hi, widx, nw); }
constexpr int MOE1_Q1 = 12500, MOE1_Q2 = 16384, MOE1_NIT = 24576;

__global__ void __launch_bounds__(NWAVES * 64, 2) mega(Args args_by_value) {
    const Args& args = *(const Args*)__builtin_amdgcn_kernarg_segment_ptr();
    extern __shared__ __attribute__((aligned(16))) unsigned char lds_raw[];
    Frame F;
    F.lds = (LAS unsigned char*)lds_raw;
    F.MISC = (volatile LAS unsigned*)(F.lds + MISC_OFF);
    F.tid = threadIdx.x; F.lane = F.tid & 63; F.wave = __builtin_amdgcn_readfirstlane(F.tid >> 6);
    F.G = gridDim.x; F.gw = blockIdx.x * NWAVES + F.wave; F.NGW = F.G * NWAVES;
    for (int u = F.tid; u < (LDS_BYTES - MISC_OFF) / 4; u += NWAVES * 64) ((LAS unsigned*)(F.lds + MISC_OFF))[u] = 0u;
    __syncthreads();
    const int lo = args.ph_lo, hi = args.ph_hi;
    XcdBarrier bar; bar.bar = args.bar; bar.x = 0; bar.st = nullptr;
    if (hi - lo > 1) bar = xcd_barrier_post(args.bar, F.MISC + 8);
#define REFRAME() do { int t_ = threadIdx.x; asm volatile("" : "+v"(t_)); F.tid = t_; F.lane = t_ & 63; F.wave = __builtin_amdgcn_readfirstlane(t_ >> 6); F.gw = blockIdx.x * NWAVES + F.wave; } while (0)
#define IN(k) (lo <= (k) && (k) < hi)
#define SEAM(k) do { if (IN(k) && IN((k) + 1)) xcd_barrier(bar); } while (0)

    if (IN(0)) { REFRAME(); p0_convert(F, args); } SEAM(0);
    if (IN(1)) { REFRAME();
        const int G1 = (args.cmask & 128) ? (F.G >= 256 ? 216 : F.G) : F.G;
        if ((int)blockIdx.x < G1) {
            fg::PlainSched S{(const char*)args.xb, (const char*)args.Wt_in, 2048, 2048, 64, 20, G1, (int)blockIdx.x, 1 << 30, 0};
            fg::EpiBf16<0> E{args.Hb, 5120, nullptr, nullptr, 0};
            fg::gemm_phase<fg::EpiBf16<0>, fg::PlainSched, false>(F.lds, 2048, 2048, 2048, S, E);
        }
        if (args.cmask & 128) { if (G1 < F.G) { if ((int)blockIdx.x >= G1) moe_convert_range(F, args, 0, MOE0_QA, 24576, ((int)blockIdx.x - G1) * NWAVES + F.wave, (F.G - G1) * NWAVES); }
                                else moe_convert_range(F, args, 0, MOE0_QA, 24576, F.gw, F.NGW); }
    } SEAM(1);
    if (IN(2)) { REFRAME();
        for (int tk = F.gw; tk < 2048; tk += F.NGW) s5_end_task(args, tk >> 9, (tk >> 4) & 31, tk & 15, F.lane);
    } SEAM(2);
    if (IN(3)) { REFRAME();
        const bool roles = F.G * NWAVES == 2048;
        if (roles) { if (F.wave < 4) for (int j = 0; j < 2; ++j) { const int tk = (int)blockIdx.x * 8 + F.wave + 4 * j; s5_out_task(args, (LAS float*)(F.lds + F.wave * WSCR), tk >> 9, (tk >> 4) & 31, tk & 15, F.lane); } }
        else for (int tk = F.gw; tk < 2048; tk += F.NGW) s5_out_task(args, (LAS float*)(F.lds + F.wave * WSCR), tk >> 9, (tk >> 4) & 31, tk & 15, F.lane);
        {
            const int na = roles ? (F.wave < 4 ? 2 : 4) : (F.gw < 4 * 12 * 128 ? (4 * 12 * 128 - 1 - F.gw) / F.NGW + 1 : 0), a0 = F.wave < 4 ? 16 + 2 * F.wave : 4 * (F.wave - 4);
            bf16x8 qf[8]; int it = roles ? (int)blockIdx.x * 8 + (a0 & 7) + 2048 * (a0 >> 3) : F.gw;
            if (na > 0) { const int qb = 127 - (it % 128), h = (it / 128) % 12, b = it / 1536; attn_stage(args.Hb, F.lds + F.wave * WSCR, b, h, qb * 32, F.lane); attn_load_q(args.Hb, b, h, qb, F.lane, qf); }
            for (int i = 0; i < na; ++i) { const int qb = 127 - (it % 128), h = (it / 128) % 12, b = it / 1536;
                const int aidn = a0 + i + 1, itn = roles ? (int)blockIdx.x * 8 + (aidn & 7) + 2048 * (aidn >> 3) : it + F.NGW; const int nqb = 127 - (itn % 128), nh = (itn / 128) % 12, nb = itn / 1536;
                attn_task(args.Hb, args.Ycat, 2048, 512, F.lds + F.wave * WSCR, b, h, qb, F.lane, qf, i + 1 < na, nb, nh, nqb); it = itn; }
        }
    } SEAM(3);
    if (IN(4)) { REFRAME();
        fg::PlainSched S{(const char*)args.Gs, (const char*)args.Wt_glu, 512, 512, 64, 2, F.G, (int)blockIdx.x, 1 << 30, 0};
        fg::EpiBf16<2> E{args.Ycat, 2048, args.in[11], args.Gs, 512};
        fg::gemm_phase<fg::EpiBf16<2>, fg::PlainSched, false>(F.lds, 512, 512, 512, S, E);
        if ((args.cmask & 256) && (int)blockIdx.x >= 192) {
            const int widx = ((int)blockIdx.x - 192) * NWAVES + F.wave, nw = (F.G - 192) * NWAVES;
            conv_plain(F, args.in[12], 2048, 2048, args.Wt_out, widx, nw); conv_plain(F, args.in[16], 2048, 2048, args.Wt_cout, widx, nw);
            moe_convert_range(F, args, 0, MOE0_QP4, MOE0_QA, widx, nw);
        }
        if ((int)blockIdx.x >= 128 && (int)blockIdx.x < 192) {
            fg::FoldSched S2{(const char*)args.Wt_cgrp, (const char*)args.Wcin_b, (int)blockIdx.x - 128};
            fg::EpiBf16<3> E2{args.Wt_cin, 2048, args.in[15], nullptr, 0};
            fg::gemm_phase<fg::EpiBf16<3>, fg::FoldSched, false>(F.lds, 512, 2048, 512, S2, E2);
        }
    } SEAM(4);
    if (IN(5)) { REFRAME();
        fg::PlainSched S{(const char*)args.Ycat, (const char*)args.Wt_out, 2048, 2048, 64, 8, F.G, (int)blockIdx.x, 1 << 30, 0};
        fg::EpiBf16<4> E{args.Pre, 2048, nullptr, args.xb, 2048};
        fg::gemm_phase<fg::EpiBf16<4>, fg::PlainSched, false>(F.lds, 2048, 2048, 2048, S, E);
    } SEAM(5);
#pragma unroll
    for (int layer = 0; layer < 2; ++layer) {
        const int pb = 6 + 8 * layer;
        int* cntl = args.cnt + 16 * layer;
        if (IN(pb)) { REFRAME();
            if (layer == 0) ln1_router_phase(F, args.Pre, args.in[17], args.in[18], args.in[19], args.in[20], args.h1, args.gates, cntl, args.tok_list, args.crow_list);
            else ln1_router_phase(F, args.Pre, args.in[17] + 2 * 2048, args.in[18] + 2 * 2048, args.in[19], args.in[20], args.h1, args.gates, cntl, args.tok_list, args.crow_list);
        } SEAM(pb);
        volatile LAS int* pre = (volatile LAS int*)(F.MISC + 16);
        if (IN(pb + 1) || IN(pb + 2)) {
            __syncthreads();
            if (F.tid == 0) { int acc = 0; for (int e = 0; e < 16; ++e) { pre[e] = acc; acc += (__hip_atomic_load(cntl + e, RLX_AGENT) + 255) >> 8; } pre[16] = acc; }
            __syncthreads();
        }
        if (IN(pb + 1)) { REFRAME();
            const int units = pre[16] * 8, rounds = (units + F.G - 1) / F.G; int Gp = rounds > 0 ? ((((units + rounds - 1) / rounds) + 7) & ~7) : F.G; if (Gp > F.G) Gp = F.G;
            if ((int)blockIdx.x < Gp) {
                fg::MoeSched S{(const char*)args.h1, (const char*)(args.Wt_gu + (size_t)layer * 16 * 2048 * 2048), (long)2048 * 2048 * 2, 2048, 2048, 8, Gp, (int)blockIdx.x, pre, cntl, args.tok_list, 1, args.ready + 16384 * layer, 0};
                fg::EpiSwiGlu E{args.hid};
                fg::gemm_phase<fg::EpiSwiGlu, fg::MoeSched, true>(F.lds, 2048, 2048, 2048, S, E);
            }
            { const int clo = layer == 0 ? 0 : MOE1_Q2, chi = layer == 0 ? MOE1_Q1 : MOE1_NIT;
              if (Gp < F.G) { if ((int)blockIdx.x >= Gp) moe1_convert_range(F, args, clo, chi, ((int)blockIdx.x - Gp) * NWAVES + F.wave, (F.G - Gp) * NWAVES); }
              else moe1_convert_range(F, args, clo, chi, F.gw, F.NGW); }
        } SEAM(pb + 1);
        if (IN(pb + 2)) { REFRAME();
            const int units = pre[16] * 8, rounds = (units + F.G - 1) / F.G; int Gp = rounds > 0 ? ((((units + rounds - 1) / rounds) + 7) & ~7) : F.G; if (Gp > F.G || layer == 1) Gp = F.G;
            if ((int)blockIdx.x < Gp) {
                fg::MoeSched S{(const char*)args.hid, (const char*)(args.Wt_dn + (size_t)layer * 16 * 2048 * 1024), (long)2048 * 1024 * 2, 1024, 1024, 8, Gp, (int)blockIdx.x, pre, cntl, args.tok_list, 0, args.ready + 16384 * layer, 0};
                fg::EpiScatter E{args.ffn, args.crow_list, pre};
                fg::gemm_phase<fg::EpiScatter, fg::MoeSched, false>(F.lds, 1024, 1024, 1024, S, E);
            }
            if (layer == 0) { if (Gp < F.G) { if ((int)blockIdx.x >= Gp) moe1_convert_range(F, args, MOE1_Q1, MOE1_Q2, ((int)blockIdx.x - Gp) * NWAVES + F.wave, (F.G - Gp) * NWAVES); }
                              else moe1_convert_range(F, args, MOE1_Q1, MOE1_Q2, F.gw, F.NGW); }
        } SEAM(pb + 2);
        if (IN(pb + 3)) { REFRAME();
            if (layer == 0) { ln2_phase<false>(F, args.h1, args.ffn, args.gates, args.in[17] + 2048, args.in[18] + 2048, (void*)args.h2); }
            else ln2_phase<true>(F, args.h1, args.ffn, args.gates, args.in[17] + 3 * 2048, args.in[18] + 3 * 2048, (void*)args.out);
        } SEAM(pb + 3);
        if (layer == 0) {
            if (IN(10)) { REFRAME();
                fg::PlainSched S{(const char*)args.h2, (const char*)args.Wt_cin, 2048, 2048, 64, 8, F.G, (int)blockIdx.x, 1 << 30, 0};
                fg::EpiBf16<0> E{args.Hc, 2048, nullptr, nullptr, 0};
                fg::gemm_phase<fg::EpiBf16<0>, fg::PlainSched, false>(F.lds, 2048, 2048, 2048, S, E);
            } SEAM(10);
            if (IN(11)) { REFRAME(); pool_phase(F, args.Hc, args.Pl); }
            if (IN(11) && IN(13)) xcd_barrier(bar);
            if (IN(13)) { REFRAME();
                fg::PlainSched S{(const char*)args.Pl, (const char*)args.Wt_cout, 2048, 2048, 64, 8, F.G, (int)blockIdx.x, 1 << 30, 0};
                fg::EpiBf16<4> E{args.Pre, 2048, nullptr, args.h2, 2048};
                fg::gemm_phase<fg::EpiBf16<4>, fg::PlainSched, false>(F.lds, 2048, 2048, 2048, S, E);
            } SEAM(13);
        }
    }
#undef IN
#undef SEAM
}
static void fill_args(Args& a, void* const* d_in, float* out, char* ws) {
    for (int i = 0; i < 24; ++i) a.in[i] = (const float*)d_in[i];
    a.out = out; a.ws = (unsigned char*)ws;
    auto at = [&](size_t mib) { return ws + mib * MiB; };
    a.bar = (unsigned*)at(0); a.cnt = (int*)(ws + 65536); a.ready = (unsigned*)(ws + 131072); a.gates = (float*)at(1); a.tok_list = (int*)at(2); a.crow_list = (int*)at(3); a.states = (float*)at(4); a.Wcin_b = (bf16_t*)at(6);
    a.Wt_in = (bf16_t*)at(16); a.Wt_out = (bf16_t*)at(36); a.Wt_cin = (bf16_t*)at(44); a.Wt_cout = (bf16_t*)at(52); a.Wt_cgrp = (bf16_t*)at(60); a.Wt_glu = (bf16_t*)at(62);
    a.Wt_gu = (bf16_t*)at(64); a.Wt_dn = (bf16_t*)at(320);
    a.xb = (bf16_t*)at(448); a.h1 = (bf16_t*)at(448); a.Hb = (bf16_t*)at(512); a.Pre = (bf16_t*)at(512); a.Vt = (bf16_t*)at(672); a.Gs = (bf16_t*)at(720);
    a.Ycat = (bf16_t*)at(736); a.Hc = (bf16_t*)at(736); a.hid = (bf16_t*)at(640); a.Pl = (bf16_t*)at(640); a.ffn = (bf16_t*)at(800); a.Yg = (bf16_t*)at(800); a.h2 = (bf16_t*)at(928);
}
}

extern "C" void kernel_launch(void* const* d_in, const int* in_sizes, int n_in, void* d_out, int out_size, void* d_ws, size_t ws_size, hipStream_t stream) {
    if (n_in != 24 || ws_size < 1024 * MiB) { fprintf(stderr, "kernel_launch: unexpected n_in %d or ws_size %zu\n", n_in, ws_size); return; }
    (void)in_sizes; (void)out_size;
    static int grid = 0;
    if (grid == 0) {
        int dev = 0, cus = 0, per_cu = 0;
        (void)hipGetDevice(&dev); (void)hipDeviceGetAttribute(&cus, hipDeviceAttributeMultiprocessorCount, dev);
        (void)hipFuncSetAttribute((const void*)mega, hipFuncAttributeMaxDynamicSharedMemorySize, LDS_BYTES);
        if (hipOccupancyMaxActiveBlocksPerMultiprocessor(&per_cu, (const void*)mega, NWAVES * 64, LDS_BYTES) != hipSuccess || per_cu < 1) { fprintf(stderr, "kernel_launch: occupancy query says %d blocks per CU\n", per_cu); per_cu = 1; }
        (void)hipGetLastError();
        grid = cus;
    }
    Args a{}; fill_args(a, d_in, (float*)d_out, (char*)d_ws);
    a.ph_lo = 0; a.ph_hi = 18; a.cmask = 31 | 128 | 256; a.pad = 0;
    (void)hipMemsetAsync(d_ws, 0, 1 * MiB, stream);
    void* kargs[] = {(void*)&a};
    hipError_t e = hipLaunchCooperativeKernel((const void*)mega, dim3(grid), dim3(NWAVES * 64), kargs, LDS_BYTES, stream);
    if (e != hipSuccess) fprintf(stderr, "kernel_launch: cooperative launch failed: %s (grid %d)\n", hipGetErrorString(e), grid);
}
```

```cpp
#include <hip/hip_runtime.h>
#include <cstdio>
#include <cstdint>

namespace {
constexpr size_t MiB = 1u << 20;
#define LAS __attribute__((address_space(3)))
#define GAS __attribute__((address_space(1)))
typedef unsigned short bf16_t;
typedef short bf16x8 __attribute__((ext_vector_type(8)));
typedef float f32x4 __attribute__((ext_vector_type(4)));
typedef float f32x2 __attribute__((ext_vector_type(2)));
typedef float f32x16 __attribute__((ext_vector_type(16)));
typedef unsigned u32x4 __attribute__((ext_vector_type(4)));
typedef unsigned u32x2 __attribute__((ext_vector_type(2)));
#define LDS_WAIT() asm volatile("s_waitcnt lgkmcnt(0)" ::: "memory")
#define VM_WAIT() asm volatile("s_waitcnt vmcnt(0)" ::: "memory")
#define DI __device__ __forceinline__

DI unsigned f2bf(float f) { unsigned u = __builtin_bit_cast(unsigned, f); return (u + 0x7fffu + ((u >> 16) & 1u)) >> 16; }

DI unsigned pk2(float lo, float hi);
DI float bf2f(unsigned short b) { return __builtin_bit_cast(float, ((unsigned)b) << 16); }
DI float bflo(unsigned w) { return __builtin_bit_cast(float, w << 16); }
DI float bfhi(unsigned w) { return __builtin_bit_cast(float, w & 0xffff0000u); }
typedef __bf16 hwbf16x2 __attribute__((ext_vector_type(2)));
DI unsigned cvt_pk_bf16(float lo, float hi) { const f32x2 v = {lo, hi}; return __builtin_bit_cast(unsigned, __builtin_convertvector(v, hwbf16x2)); }

namespace fg {
constexpr int KLOOP_PAD_DWORDS = 0;
constexpr int BM = 256, BK = 64, HALF = 128, HTB = HALF * BK * 2, STAGE_BYTES = 8 * HTB, NXCD = 8, WGM = 8;
__host__ __device__ __forceinline__ int lds_byte(int r, int c) { const int st = (r >> 4) * 2 + (c >> 5), rr = r & 15, cc = c & 31, ob = rr * 64 + cc * 2; return st * 1024 + (ob ^ (((ob >> 9) & 1) << 5)); }
__host__ __device__ __forceinline__ void stage_rc(int b, int& R, int& C) { const int st = b / 1024, sb = b % 1024, swz = sb ^ (((sb >> 9) & 1) << 5); R = (st >> 1) * 16 + swz / 64; C = (st & 1) * 32 + (swz % 64) / 2; }
__host__ __device__ __forceinline__ int perm32(int rho) { const int n = rho >> 4, i = rho & 15; return 8 * (i >> 2) + 4 * n + (i & 3); }

struct Unit { const char* a; const char* b; int pm, pn, e, lim; };

DI void tile_of(int wgid, int nM, int nN, int& pm, int& pn) {
    const int nwg = nM * nN;
    { const int q = nwg / NXCD, r = nwg % NXCD, xcd = wgid % NXCD, off = wgid / NXCD; wgid = (xcd < r ? xcd * (q + 1) : r * (q + 1) + (xcd - r) * q) + off; }
    const int nig = WGM * nN, gid = wgid / nig, fm = gid * WGM, gsz = (nM - fm) < WGM ? (nM - fm) : WGM;
    pm = fm + ((wgid % nig) % gsz); pn = (wgid % nig) / gsz;
}
struct PlainSched {       static constexpr bool MASKED = false;
    const char* A; const char* B; int lda, ldb, nM, nN, G, c, apn_div; long apn_bytes;
    DI bool next(int i, Unit& u) const {
        const long L = (long)i * G + c; if (L >= (long)nM * nN) return false;
        int pm, pn; tile_of((int)L, nM, nN, pm, pn);
        u.pm = pm; u.pn = pn; u.e = 0; u.lim = 256;
        u.a = A + (size_t)pm * 256 * lda * 2 + (size_t)(pn / apn_div) * apn_bytes; u.b = B + (size_t)pn * 256 * ldb * 2; return true;
    }
    DI int arow(const Unit&, int R) const { return R; }
    DI void a_ready(const Unit&) const {}
    DI void done(const Unit&) const {}
};
struct FoldSched {
    static constexpr bool MASKED = false;
    const char* A; const char* B; int u;
    DI bool next(int i, Unit& un) const {
        if (i > 0) return false;
        const int g = u >> 4, pm2 = (u >> 3) & 1, pn = u & 7;
        un.pm = 2 * g + pm2; un.pn = pn; un.e = 0; un.lim = 256;
        un.a = A + (size_t)(g * 512 + pm2 * 256) * 512 * 2; un.b = B + ((size_t)pn * 256 * 2048 + g * 512) * 2; return true;
    }
    DI int arow(const Unit&, int R) const { return R; }
    DI void a_ready(const Unit&) const {}
    DI void done(const Unit&) const {}
};
struct MoeSched {
    static constexpr bool MASKED = false;
    const char* A; const char* B; long b_estride; int lda, ldb, nN, G, c; const volatile LAS int* pre; const int* cnt; const int* list; int gather; unsigned* ready; int dep;
    DI bool next(int i, Unit& u) const {
        const int nM = pre[16]; const long L = (long)i * G + c; if (L >= (long)nM * nN) return false;
        int pm, pn; tile_of((int)L, nM, nN, pm, pn);
        int e = 0;
#pragma unroll
        for (int j = 1; j < 16; ++j) e += (pm >= pre[j]) ? 1 : 0;
        const int mt = pm - pre[e]; const int lim = pre[17 + e] - mt * 256;
        u.pm = pm; u.pn = pn; u.e = e; u.lim = lim < 256 ? lim : 256;
        u.a = gather ? A : A + (size_t)pm * 256 * lda * 2; u.b = B + (size_t)e * b_estride + (size_t)pn * 256 * ldb * 2; return true;
    }
    DI int arow(const Unit& u, int R) const {
        const int mt = u.pm - pre[u.e];
        return list[u.e * 16384 + mt * 256 + ((R < u.lim) ? R : 0)];
    }
    DI void done(const Unit& u) const {
        if (dep == 1) {
            asm volatile("s_waitcnt vmcnt(0)" ::: "memory");
            asm volatile("" ::: "memory"); __builtin_amdgcn_s_barrier(); asm volatile("" ::: "memory");
            if (threadIdx.x == 0) __hip_atomic_fetch_add(ready + 64 * u.pm, 1u, __ATOMIC_RELAXED, __HIP_MEMORY_SCOPE_AGENT);
        }
    }
    DI void a_ready(const Unit& u) const {
        if (dep == 2) {
            if (threadIdx.x < 64) {
                unsigned polls = 0;
                while ((unsigned)__builtin_amdgcn_readfirstlane(__hip_atomic_load(ready + 64 * u.pm, __ATOMIC_RELAXED, __HIP_MEMORY_SCOPE_AGENT)) < 8u) {
                    __builtin_amdgcn_s_sleep(2); if (++polls > (1u << 22)) break; }
                __builtin_amdgcn_fence(__ATOMIC_ACQUIRE, "agent");
                asm volatile("s_waitcnt vmcnt(0)" ::: "memory");
            }
            asm volatile("" ::: "memory"); __builtin_amdgcn_s_barrier(); asm volatile("" ::: "memory");
        }
    }
};

struct EpiF32 {
    static constexpr bool PERM = false;
    float* C; int ldc;
    DI void operator()(const f32x4 (&acc)[2][2][4][2], const Unit& u, int wr, int wc, int fr, int fq) const {
        const int row0 = u.pm * BM + wr * 64 + fr, col0 = u.pn * BM + wc * 32 + 4 * fq;
#pragma unroll
        for (int ai = 0; ai < 2; ++ai)
#pragma unroll
            for (int m = 0; m < 4; ++m) { float* rowp = C + (size_t)(row0 + ai * HALF + m * 16) * ldc + col0;
#pragma unroll
                for (int bj = 0; bj < 2; ++bj)
#pragma unroll
                    for (int n = 0; n < 2; ++n) *(f32x4*)(rowp + bj * HALF + n * 16) = acc[ai][bj][m][n]; }
    }
};
template <int MODE  > struct EpiBf16 {
    static constexpr bool PERM = true;
    bf16_t* O; int ldc; const float* cs; const bf16_t* Gm; int ldg;
    DI void operator()(const f32x4 (&acc)[2][2][4][2], const Unit& u, int wr, int wc, int fr, int fq) const {
        const int row0 = u.pm * BM + wr * 64 + fr; const int col0 = u.pn * BM + wc * 32 + 8 * fq;
        f32x4 cv[2][2];
#pragma unroll
        for (int bj = 0; bj < 2; ++bj)
#pragma unroll
            for (int n = 0; n < 2; ++n) cv[bj][n] = (MODE == 1 || MODE == 2) ? *(const f32x4*)(cs + col0 + bj * HALF + 4 * n) : (f32x4){0.f, 0.f, 0.f, 0.f};
#pragma unroll
        for (int ai = 0; ai < 2; ++ai) {
            u32x4 gpre[4][2]; float rspre[4];
#pragma unroll
            for (int m = 0; m < 4; ++m) { const size_t row = (size_t)(row0 + ai * HALF + m * 16);
                if (MODE == 3) rspre[m] = cs[row];
                if (MODE == 4 || MODE == 2) {
#pragma unroll
                    for (int bj = 0; bj < 2; ++bj) gpre[m][bj] = *(const u32x4*)(Gm + row * ldg + col0 + bj * HALF); } }
#pragma unroll
            for (int m = 0; m < 4; ++m) { const size_t row = (size_t)(row0 + ai * HALF + m * 16); bf16_t* rowp = O + row * ldc + col0;
#pragma unroll
                for (int bj = 0; bj < 2; ++bj) { f32x4 v0 = acc[ai][bj][m][0], v1 = acc[ai][bj][m][1];
                    if (MODE == 1) { v0 = v0 * cv[bj][0]; v1 = v1 * cv[bj][1]; }
                    if (MODE == 3) { const float rs = rspre[m]; v0 = v0 * rs; v1 = v1 * rs; }
                    if (MODE == 4) {
                        const u32x4 gw = gpre[m][bj];
                        v0 = v0 + 1.41421356237309515f * (f32x4){bflo(gw.x), bfhi(gw.x), bflo(gw.y), bfhi(gw.y)}; v1 = v1 + 1.41421356237309515f * (f32x4){bflo(gw.z), bfhi(gw.z), bflo(gw.w), bfhi(gw.w)};
                    }
                    if (MODE == 2) {
                        const u32x4 gw = gpre[m][bj];
                        v0 = v0 + cv[bj][0]; v1 = v1 + cv[bj][1];
                        const float g[8] = {bflo(gw.x), bfhi(gw.x), bflo(gw.y), bfhi(gw.y), bflo(gw.z), bfhi(gw.z), bflo(gw.w), bfhi(gw.w)};
#pragma unroll
                        for (int j = 0; j < 4; ++j) { v0[j] = g[j] * __builtin_amdgcn_rcpf(1.f + __expf(-v0[j])); v1[j] = g[4 + j] * __builtin_amdgcn_rcpf(1.f + __expf(-v1[j])); }
                    }
                    u32x4 w; w.x = cvt_pk_bf16(v0[0], v0[1]); w.y = cvt_pk_bf16(v0[2], v0[3]); w.z = cvt_pk_bf16(v1[0], v1[1]); w.w = cvt_pk_bf16(v1[2], v1[3]);
                    *(u32x4*)(rowp + bj * HALF) = w; } } }
    }
};
struct EpiSwiGlu {
    static constexpr bool PERM = false;
    bf16_t* Hd;
    DI void operator()(const f32x4 (&acc)[2][2][4][2], const Unit& u, int wr, int wc, int fr, int fq) const {
        const int row0 = u.pm * BM + wr * 64 + fr; const int col0 = u.pn * 128 + wc * 16 + 8 * (fq >> 1) + 64 * (fq & 1);
#pragma unroll
        for (int ai = 0; ai < 2; ++ai)
#pragma unroll
            for (int m = 0; m < 4; ++m) { bf16_t* rowp = Hd + (size_t)(row0 + ai * HALF + m * 16) * 1024 + col0;
                u32x2 w[2];
#pragma unroll
                for (int bj = 0; bj < 2; ++bj) { const f32x4 g = acc[ai][bj][m][0], up = acc[ai][bj][m][1]; f32x4 h;
#pragma unroll
                    for (int j = 0; j < 4; ++j) h[j] = g[j] * __builtin_amdgcn_rcpf(1.f + __expf(-g[j])) * up[j];
                    w[bj].x = cvt_pk_bf16(h[0], h[1]); w[bj].y = cvt_pk_bf16(h[2], h[3]); }
                const auto sx = __builtin_amdgcn_permlane16_swap(w[0].x, w[1].x, false, false), sy = __builtin_amdgcn_permlane16_swap(w[0].y, w[1].y, false, false);
                u32x4 o; o.x = sx[0]; o.y = sy[0]; o.z = sx[1]; o.w = sy[1];
                *(u32x4*)rowp = o; }
    }
};
struct EpiScatter {
    static constexpr bool PERM = true;
    bf16_t* F; const int* crow; const volatile LAS int* pre;
    DI void operator()(const f32x4 (&acc)[2][2][4][2], const Unit& u, int wr, int wc, int fr, int fq) const {
        const int mt = u.pm - pre[u.e]; const int col0 = u.pn * BM + wc * 32 + 8 * fq;
        int dsts[2][4];
#pragma unroll
        for (int ai = 0; ai < 2; ++ai)
#pragma unroll
            for (int m = 0; m < 4; ++m) dsts[ai][m] = crow[u.e * 16384 + mt * 256 + ai * HALF + wr * 64 + m * 16 + fr];
#pragma unroll
        for (int ai = 0; ai < 2; ++ai)
#pragma unroll
            for (int m = 0; m < 4; ++m) { const int R = ai * HALF + wr * 64 + m * 16 + fr;
                if (R < u.lim) { const int dst = dsts[ai][m]; bf16_t* rowp = F + (size_t)dst * 2048 + col0;
#pragma unroll
                    for (int bj = 0; bj < 2; ++bj) { const f32x4 v0 = acc[ai][bj][m][0], v1 = acc[ai][bj][m][1];
                        u32x4 w; w.x = cvt_pk_bf16(v0[0], v0[1]); w.y = cvt_pk_bf16(v0[2], v0[3]); w.z = cvt_pk_bf16(v1[0], v1[1]); w.w = cvt_pk_bf16(v1[2], v1[3]);
                        *(u32x4*)(rowp + bj * HALF) = w; } } }
    }
};

template <class Epi, class Sched, bool GATHER>
__device__ __forceinline__ void gemm_phase(LAS unsigned char* lds, const int lda, const int ldb, const int K, const Sched& S, const Epi& E) {
    int tid_ = threadIdx.x; asm volatile("" : "+v"(tid_));
    const int tid = tid_, wid = __builtin_amdgcn_readfirstlane(tid >> 6), lane = tid & 63, wr = wid >> 2, wc = wid & 3, fr = lane & 15, fq = lane >> 4;
    const int nt = K / BK;
    Unit cur, nxt; int ui = 0;
    if (!S.next(0, cur)) return;
    unsigned voffA[2][2], voffB[2];
#pragma unroll
    for (int i = 0; i < 2; ++i) { int R, C; stage_rc(tid * 16 + i * 8192, R, C); const int Rb = Epi::PERM ? ((R & ~31) + perm32(R & 31)) : R;
        voffB[i] = (unsigned)(Rb * ldb + C) * 2u;
#pragma unroll
        for (int h = 0; h < 2; ++h) voffA[h][i] = (unsigned)((GATHER ? S.arow(cur, R + 128 * h) : (R + 128 * h)) * lda + C) * 2u; }
    const size_t kstep = (size_t)(BK * 2);
    const size_t hstepB = (size_t)HALF * ldb * 2;
    const unsigned ldsw = (unsigned)wid * 1024u;
    const int aoff = lds_byte(wr * 64 + fr, fq * 8), boff = lds_byte(wc * 32 + fr, fq * 8);
#define PG8_SA(b, h) (((b) * 2 + (h)) * HTB)
#define PG8_SB(b, h) ((4 + (b) * 2 + (h)) * HTB)
#define PG8_STAGE(bufoff, gbase, voff) do { _Pragma("unroll") for (int _i = 0; _i < 2; ++_i) \
        __builtin_amdgcn_global_load_lds((const unsigned*)((const char*)(gbase) + (voff)[_i]), (LAS unsigned*)(lds + (bufoff) + ldsw + _i * 8192), 16, 0, 0); } while (0)
#define PG8_LDA(dst, b, h) do { _Pragma("unroll") for (int m = 0; m < 4; ++m) _Pragma("unroll") for (int k = 0; k < 2; ++k) dst[m][k] = *(const LAS bf16x8*)(lds + PG8_SA(b, h) + aoff + m * 2048 + k * 1024); } while (0)
#define PG8_LDB(dst, b, h) do { _Pragma("unroll") for (int n = 0; n < 2; ++n) _Pragma("unroll") for (int k = 0; k < 2; ++k) dst[n][k] = *(const LAS bf16x8*)(lds + PG8_SB(b, h) + boff + n * 2048 + k * 1024); } while (0)
#define PG8_MMA_(ai, bj, At, Bt) do { _Pragma("unroll") for (int m = 0; m < 4; ++m) _Pragma("unroll") for (int n = 0; n < 2; ++n) _Pragma("unroll") for (int k = 0; k < 2; ++k) \
        acc[ai][bj][m][n] = __builtin_amdgcn_mfma_f32_16x16x32_bf16(Bt[n][k], At[m][k], acc[ai][bj][m][n], 0, 0, 0); } while (0)
#define PG8_MMA2(ai, At, Ba, Bb) do { __builtin_amdgcn_s_setprio(1); PG8_MMA_(ai, 0, At, Ba); PG8_MMA_(ai, 1, At, Bb); __builtin_amdgcn_s_setprio(0); } while (0)
#define PG8_WAIT_V(n) asm volatile("s_waitcnt vmcnt(" #n ")" ::: "memory")
#define PG8_WAIT_L(n) asm volatile("s_waitcnt lgkmcnt(" #n ")" ::: "memory")
#define PG8_BAR __builtin_amdgcn_s_barrier()
#define PG8_SCHED __builtin_amdgcn_sched_barrier(0)
    f32x4 acc[2][2][4][2];
#pragma unroll
    for (int a = 0; a < 2; ++a)
#pragma unroll
        for (int b = 0; b < 2; ++b)
#pragma unroll
            for (int m = 0; m < 4; ++m)
#pragma unroll
                for (int n = 0; n < 2; ++n) acc[a][b][m][n] = (f32x4){0.f, 0.f, 0.f, 0.f};
    bf16x8 At[4][2], B0[2][2], B1[2][2];
    const char* cA = cur.a; const char* cB = cur.b;
    bool need[2] = {64 * wr < cur.lim, 128 + 64 * wr < cur.lim};
    S.a_ready(cur);
    PG8_STAGE(PG8_SB(0, 0), cB, voffB); PG8_STAGE(PG8_SB(0, 1), cB + hstepB, voffB); PG8_STAGE(PG8_SA(0, 0), cA, voffA[0]); PG8_STAGE(PG8_SA(0, 1), cA, voffA[1]);
    if (wr == 1) PG8_BAR;
    PG8_WAIT_V(2); PG8_BAR;
    PG8_STAGE(PG8_SB(1, 0), cB + kstep, voffB); PG8_STAGE(PG8_SA(1, 0), cA + kstep, voffA[0]); PG8_STAGE(PG8_SB(1, 1), cB + hstepB + kstep, voffB);
    PG8_WAIT_V(6); PG8_BAR;
    for (;;) {
        const bool has_next = S.next(ui + 1, nxt);
        const char* nA = has_next ? nxt.a : cA; const char* nB = has_next ? nxt.b : cB;
        for (int t = 0; t < nt; t += 2) {
            asm volatile(".p2align 6");
            const bool last = (t == nt - 2);
            const char* a1 = cA + (size_t)(t + 1) * kstep;
            const char* a2 = last ? nA : cA + (size_t)(t + 2) * kstep; const char* b2 = last ? nB : cB + (size_t)(t + 2) * kstep;
            const char* a3 = a2 + kstep; const char* b3 = b2 + kstep;
            if (last && has_next) S.a_ready(nxt);
            PG8_LDB(B0, 0, 0); PG8_LDB(B1, 0, 1); PG8_SCHED; PG8_LDA(At, 0, 0); PG8_STAGE(PG8_SA(1, 1), a1, voffA[1]);
            PG8_WAIT_V(8); PG8_WAIT_L(0); PG8_BAR; PG8_MMA2(0, At, B0, B1); PG8_BAR; PG8_SCHED;
            if (GATHER) { if (last && has_next) {
#pragma unroll
                for (int i = 0; i < 2; ++i) { int R, C; stage_rc(tid * 16 + i * 8192, R, C);
#pragma unroll
                    for (int h = 0; h < 2; ++h) voffA[h][i] = (unsigned)(S.arow(nxt, R + 128 * h) * lda + C) * 2u; } } }
            PG8_LDA(At, 0, 1); PG8_STAGE(PG8_SB(0, 0), b2, voffB); PG8_STAGE(PG8_SB(0, 1), b2 + hstepB, voffB); PG8_STAGE(PG8_SA(0, 0), a2, voffA[0]);
            PG8_WAIT_V(8); PG8_WAIT_L(0); PG8_BAR; PG8_MMA2(1, At, B0, B1); PG8_BAR; PG8_SCHED;
            PG8_LDB(B0, 1, 0); PG8_LDB(B1, 1, 1); PG8_SCHED; PG8_LDA(At, 1, 0); PG8_STAGE(PG8_SA(0, 1), a2, voffA[1]);
            PG8_WAIT_V(8); PG8_WAIT_L(0); PG8_BAR; PG8_MMA2(0, At, B0, B1); PG8_BAR; PG8_SCHED;
            PG8_LDA(At, 1, 1); PG8_STAGE(PG8_SB(1, 0), b3, voffB); PG8_STAGE(PG8_SB(1, 1), b3 + hstepB, voffB); PG8_STAGE(PG8_SA(1, 0), a3, voffA[0]);
            PG8_WAIT_V(8); PG8_WAIT_L(0); PG8_BAR; PG8_MMA2(1, At, B0, B1); PG8_BAR; PG8_SCHED;
        }
        if (wr == 0) PG8_BAR;
        E(acc, cur, wr, wc, fr, fq); S.done(cur);
        if (!has_next) break;
#pragma unroll
        for (int a = 0; a < 2; ++a)
#pragma unroll
            for (int b = 0; b < 2; ++b)
#pragma unroll
                for (int m = 0; m < 4; ++m)
#pragma unroll
                    for (int n = 0; n < 2; ++n) acc[a][b][m][n] = (f32x4){0.f, 0.f, 0.f, 0.f};
        cur = nxt; cA = nA; cB = nB; ++ui; need[0] = 64 * wr < cur.lim; need[1] = 128 + 64 * wr < cur.lim;
        if (wr == 1) PG8_BAR;
    }
    PG8_WAIT_V(0);
    PG8_BAR;
#undef PG8_SA
#undef PG8_SB
#undef PG8_STAGE
#undef PG8_LDA
#undef PG8_LDB
#undef PG8_MMA_
#undef PG8_MMA2
#undef PG8_WAIT_V
#undef PG8_WAIT_L
#undef PG8_BAR
#undef PG8_SCHED
}
}

DI unsigned pk2(float lo, float hi) { return cvt_pk_bf16(lo, hi); }
#define MFMA32(a, b, c) __builtin_amdgcn_mfma_f32_32x32x16_bf16((a), (b), (c), 0, 0, 0)
DI bf16x8 pack8(float x0, float x1, float x2, float x3, float x4, float x5, float x6, float x7) {
    u32x4 p; p.x = cvt_pk_bf16(x0, x1); p.y = cvt_pk_bf16(x2, x3); p.z = cvt_pk_bf16(x4, x5); p.w = cvt_pk_bf16(x6, x7);
    return __builtin_bit_cast(bf16x8, p);
}
constexpr float SB_EXIT = -36.8f;

DI void attn_stage(const bf16_t* Hb, LAS unsigned char* scr, int b, int h, int key0, int lane_in) {
    int lane = lane_in; asm volatile("" : "+v"(lane));
#pragma unroll
    for (int i = 0; i < 8; ++i) {
        const int rr = 4 * i + (lane >> 4), lc = (lane & 15) ^ (rr & 15);
        const int pir = (rr & ~12) | ((rr & 4) << 1) | ((rr & 8) >> 1);
        __builtin_amdgcn_global_load_lds((const unsigned*)(Hb + (size_t)(b * 4096 + key0 + pir) * 5120 + 2048 + h * 128 + lc * 8), (LAS unsigned*)(scr + i * 1024), 16, 0, 0);
    }
#pragma unroll
    for (int i = 0; i < 8; ++i) {
        const int rw = 4 * i + (lane >> 4), lc = (lane & 15) ^ (((rw & 3) << 2) | ((rw >> 2) & 3));
        __builtin_amdgcn_global_load_lds((const unsigned*)(Hb + (size_t)(b * 4096 + key0 + rw) * 5120 + 3584 + h * 128 + lc * 8), (LAS unsigned*)(scr + 8192 + i * 1024), 16, 0, 0);
    }
}
typedef short s16x4 __attribute__((ext_vector_type(4)));
DI s16x4 v_tr_read(LAS unsigned char* vimg, int lane, int dt, int s, int t) {
    const int hh = lane >> 5, blk = (lane >> 4) & 1, q = (lane & 15) >> 2, p = lane & 3;
    const int row = 16 * s + 8 * hh + 4 * t + q, ch = 4 * dt + 2 * blk + (p >> 1);
    const int off = 256 * row + 16 * (ch ^ (((row & 3) << 2) | ((row >> 2) & 3))) + 8 * (p & 1);
    return __builtin_amdgcn_ds_read_tr16_b64_v4i16((LAS s16x4*)(vimg + off));
}
template <bool DIAG>
DI bool attn_tile(const bf16_t* Hb, LAS unsigned char* scr, const bf16x8 (&qf)[8], f32x16 (&o)[4], float& R, int b, int h, int kt, int qpos, int lane, const LAS unsigned char* kaddr, int ksw, int hh) {
    const int key0 = kt * 32;
    const float scale2 = 0.08838834764831845f * 1.4426950408889634f;
    asm volatile("s_waitcnt vmcnt(0)" ::: "memory");
    bf16x8 kf[8], vf[4][2];
#pragma unroll
    for (int ks = 0; ks < 8; ++ks) kf[ks] = *(const LAS bf16x8*)(kaddr + (((2 * ks + hh) ^ ksw) << 4));
#pragma unroll
    for (int dt = 0; dt < 4; ++dt)
#pragma unroll
        for (int s = 0; s < 2; ++s) { const s16x4 lo = v_tr_read(scr + 8192, lane, dt, s, 0), hi = v_tr_read(scr + 8192, lane, dt, s, 1);
            vf[dt][s] = __builtin_shufflevector(lo, hi, 0, 1, 2, 3, 4, 5, 6, 7); }
    asm volatile("s_waitcnt lgkmcnt(0)" ::: "memory");
    if (kt > 0) attn_stage(Hb, scr, b, h, key0 - 32, lane);
    f32x16 st;
#pragma unroll
    for (int i = 0; i < 16; ++i) st[i] = 0.f;
#pragma unroll
    for (int ks = 0; ks < 8; ++ks) st = MFMA32(kf[ks], qf[ks], st);
    float z[16], lk[16];
#pragma unroll
    for (int i = 0; i < 16; ++i) {
        z[i] = st[i] * scale2;
        const float sp = fmaxf(z[i], 0.f) + __builtin_amdgcn_logf(1.f + __builtin_amdgcn_exp2f(-fabsf(z[i])));
        if (DIAG) { const bool valid = key0 + 16 * (i >> 3) + 8 * hh + (i & 7) < qpos; lk[i] = valid ? -sp : 0.f; z[i] = valid ? z[i] : -1e30f; }
        else lk[i] = -sp;
    }
#pragma unroll
    for (int i = 6; i >= 0; --i) { lk[i] += lk[i + 1]; lk[8 + i] += lk[8 + i + 1]; }
    const float tA = lk[0], tB = lk[8];
    const float pA = __shfl_xor(tA, 32), pB = __shfl_xor(tB, 32);
    const float offB = hh ? 0.f : pB;
    const float offA = hh ? (tB + pB) : (pB + tB + pA);
    const float cA = R + offA, cB = R + offB;
    float w[16];
#pragma unroll
    for (int i = 0; i < 8; ++i) { w[i] = __builtin_amdgcn_exp2f(z[i] + lk[i] + cA); w[8 + i] = __builtin_amdgcn_exp2f(z[8 + i] + lk[8 + i] + cB); }
    R += (tA + tB) + (pA + pB);
    const bf16x8 p0 = pack8(w[0], w[1], w[2], w[3], w[4], w[5], w[6], w[7]);
    const bf16x8 p1 = pack8(w[8], w[9], w[10], w[11], w[12], w[13], w[14], w[15]);
#pragma unroll
    for (int dt = 0; dt < 4; ++dt) { o[dt] = MFMA32(vf[dt][0], p0, o[dt]); o[dt] = MFMA32(vf[dt][1], p1, o[dt]); }
    return __builtin_amdgcn_ballot_w64(R >= SB_EXIT * 1.4426950408889634f) == 0ull;
}
DI void attn_task(const bf16_t* Hb, bf16_t* Y, int ldy, int ycol0, LAS unsigned char* scr, int b, int h, int qb, int lane) {
    const int r = lane & 31, hh = lane >> 5;
    const int t0 = qb * 32;
    attn_stage(Hb, scr, b, h, t0, lane);
    const bf16_t* qrow = Hb + (size_t)(b * 4096 + t0 + r) * 5120 + 512 + h * 128 + 8 * hh;
    bf16x8 qf[8];
#pragma unroll
    for (int ks = 0; ks < 8; ++ks) qf[ks] = *(const bf16x8*)(qrow + 16 * ks);
    f32x16 o[4];
#pragma unroll
    for (int dt = 0; dt < 4; ++dt)
#pragma unroll
        for (int i = 0; i < 16; ++i) o[dt][i] = 0.f;
    float R = 0.f;
    const int qpos = t0 + r;
    const LAS unsigned char* kaddr = scr + r * 256; const int ksw = r & 15;
    if (!attn_tile<true>(Hb, scr, qf, o, R, b, h, qb, qpos, lane, kaddr, ksw, hh))
        for (int kt = qb - 1; kt >= 0; --kt) if (attn_tile<false>(Hb, scr, qf, o, R, b, h, kt, qpos, lane, kaddr, ksw, hh)) break;
    asm volatile("s_waitcnt vmcnt(0)" ::: "memory");
    bf16_t* yrow = Y + (size_t)(b * 4096 + t0 + r) * ldy + ycol0 + h * 128 + 8 * hh;
#pragma unroll
    for (int dt = 0; dt < 4; ++dt)
#pragma unroll
        for (int j = 0; j < 2; ++j) {
            const unsigned ax = cvt_pk_bf16(o[dt][8 * j], o[dt][8 * j + 1]), ay = cvt_pk_bf16(o[dt][8 * j + 2], o[dt][8 * j + 3]);
            const unsigned bx = cvt_pk_bf16(o[dt][8 * j + 4], o[dt][8 * j + 5]), by = cvt_pk_bf16(o[dt][8 * j + 6], o[dt][8 * j + 7]);
            const auto sx = __builtin_amdgcn_permlane32_swap(ax, bx, false, false), sy = __builtin_amdgcn_permlane32_swap(ay, by, false, false);
            u32x4 wv; wv.x = sx[0]; wv.y = sy[0]; wv.z = sx[1]; wv.w = sy[1];
            *(u32x4*)(yrow + 32 * dt + 16 * j) = wv; }
}
constexpr int NWAVES = 8;
constexpr int RING_BYTES = 131072;
constexpr int WSCR = 17408;
constexpr int CODE_SHIFT_DWORDS = 0;
constexpr int MISC_OFF = 143360;
constexpr int LDS_BYTES = 147456;
typedef GAS unsigned gu32;
#define RLX_AGENT __ATOMIC_RELAXED, __HIP_MEMORY_SCOPE_AGENT

#define XB_TMO      128
#define XB_XCNT(j)  (256  + 64 * (j))
#define XB_XSUB(j)  (1280 + 64 * (j))
#define XB_XGEN(j)  (2304 + 64 * (j))
#define XB_TOP      3328
#define XB_TOPGEN   3392
#define XCD_BAR_WORDS 3456
#define XB_SPIN_CAP (1u << 22)
DI unsigned xb_ld(unsigned* p)              { return __hip_atomic_load(p, __ATOMIC_RELAXED, __HIP_MEMORY_SCOPE_AGENT); }
DI unsigned xb_add(unsigned* p, unsigned v) { return __hip_atomic_fetch_add(p, v, __ATOMIC_RELAXED, __HIP_MEMORY_SCOPE_AGENT); }
DI unsigned xb_xcc_id() { return (unsigned)__builtin_amdgcn_s_getreg((3 << 11) | 20) & 0xFu; }
#define XB_SPIN(cond, bar) do { unsigned _sp = 0; while (cond) { __builtin_amdgcn_s_sleep(1); \
    if ((++_sp & 255u) == 0u) { if (xb_ld(&(bar)[XB_TMO])) break; if (_sp > XB_SPIN_CAP) { atomicAdd(&(bar)[XB_TMO], 1u); break; } } } } while (0)
struct XcdBarrier { unsigned* bar; unsigned x; volatile LAS unsigned* st; };
DI XcdBarrier xcd_barrier_post(unsigned* bar, volatile LAS unsigned* st) {
    XcdBarrier b; b.bar = bar; b.x = xb_xcc_id(); b.st = st;
    if (threadIdx.x == 0) (void)xb_add(&bar[XB_XCNT(b.x)], 1u);
    return b;
}
DI void xcd_barrier_complete(unsigned* bar, unsigned x, unsigned& nloc, unsigned& nx) {
    const unsigned G = gridDim.x * gridDim.y * gridDim.z;
    unsigned sum, cnt, mine, sp = 0u;
    for (;;) {
        sum = 0u; cnt = 0u; mine = 0u;
#pragma unroll
        for (unsigned j = 0; j < 16; ++j) { const unsigned c = xb_ld(&bar[XB_XCNT(j)]); sum += c; cnt += (c > 0u) ? 1u : 0u; mine = (j == x) ? c : mine; }
        if (sum == G) break;
        __builtin_amdgcn_s_sleep(1);
        if ((++sp & 255u) == 0u) { if (xb_ld(&bar[XB_TMO])) break; if (sp > XB_SPIN_CAP) { atomicAdd(&bar[XB_TMO], 1u); break; } }
    }
    nloc = mine > 0u ? mine : 1u; nx = cnt > 0u ? cnt : 1u;
}
DI void xcd_barrier(const XcdBarrier& b) {
    asm volatile("s_waitcnt vmcnt(0)" ::: "memory");
    __syncthreads();
    if (threadIdx.x == 0) {
        unsigned* bar = b.bar;
        __builtin_amdgcn_s_waitcnt(0);
        unsigned nloc = b.st[0], nx = b.st[1];
        if (nloc == 0u) { xcd_barrier_complete(bar, b.x, nloc, nx); b.st[0] = nloc; b.st[1] = nx; }
        const unsigned old = xb_add(&bar[XB_XSUB(b.x)], 1u);
        const unsigned gen = old / nloc;
        if (old + 1u == (gen + 1u) * nloc) {
            __builtin_amdgcn_fence(__ATOMIC_RELEASE, "agent");
            asm volatile("s_waitcnt vmcnt(0)" ::: "memory");
            const unsigned og = xb_add(&bar[XB_TOP], 1u);
            const unsigned tg = og / nx;
            if (og + 1u == (tg + 1u) * nx) { xb_add(&bar[XB_TOPGEN], 1u); __builtin_amdgcn_fence(__ATOMIC_ACQUIRE, "agent"); }
            else { __builtin_amdgcn_fence(__ATOMIC_ACQUIRE, "agent"); XB_SPIN(xb_ld(&bar[XB_TOPGEN]) == tg, bar); }
            xb_add(&bar[XB_XGEN(b.x)], 1u);
            asm volatile("s_waitcnt vmcnt(0)" ::: "memory");
        } else {
            __builtin_amdgcn_fence(__ATOMIC_ACQUIRE, "agent");
            XB_SPIN(xb_ld(&bar[XB_XGEN(b.x)]) == gen, bar);
            asm volatile("s_waitcnt vmcnt(0)" ::: "memory");
        }
    }
    __syncthreads();
}

struct Args {
    const float* in[24]; float* out; unsigned char* ws;
    bf16_t *xb, *Wt_in, *Wt_out, *Wt_glu, *Wt_cin, *Wt_cgrp, *Wt_cout, *Wt_gu, *Wt_dn, *Wcin_b;
    bf16_t *Hb, *Vt, *Gs, *Ycat, *h1, *hid, *ffn, *h2, *Hc, *Pl, *Yg;
    bf16_t* Pre; float *states, *gates;
    int *cnt, *tok_list, *crow_list; unsigned* bar; unsigned* ready;
    int ph_lo, ph_hi, cmask, pad;
};
#define MFMA16(a, b, c) __builtin_amdgcn_mfma_f32_16x16x32_bf16((a), (b), (c), 0, 0, 0)
constexpr int S5_PITCH = 132;
DI bf16x8 pack8v(const f32x4 a, const f32x4 b) {
    u32x4 p; p.x = cvt_pk_bf16(a[0], a[1]); p.y = cvt_pk_bf16(a[2], a[3]); p.z = cvt_pk_bf16(b[0], b[1]); p.w = cvt_pk_bf16(b[2], b[3]);
    return __builtin_bit_cast(bf16x8, p);
}
DI void s5_end_task(const Args& a, int b, int g, int span, int lane) {
    const float* lam_re = a.in[2]; const float* lam_im = a.in[3]; const float* log_dt = a.in[4];
    const float* b_re = a.in[5]; const float* b_im = a.in[6];
    const bf16_t* Hb = a.Hb;
    const float dt = expf(log_dt[g]);
    const int hh = lane >> 5;
    bf16x8 bm[4]; float lr[2], li[2], l4r[2], l4i[2];
#pragma unroll
    for (int half = 0; half < 2; ++half) {
        const int n = 32 * half + (lane & 31);
        const float lrn = lam_re[g * 64 + n], lin = lam_im[g * 64 + n]; const float mag = expf(lrn * dt);
        const float er = mag * cosf(lin * dt), ei = mag * sinf(lin * dt); const float den = lrn * lrn + lin * lin;
        const float cfr = ((er - 1.f) * lrn + ei * lin) / den, cfi = (ei * lrn - (er - 1.f) * lin) / den;
        const float* brp = b_re + (size_t)(g * 64 + n) * 16 + 8 * hh; const float* bip = b_im + (size_t)(g * 64 + n) * 16 + 8 * hh;
        const f32x4 br0 = *(const f32x4*)brp, br1 = *(const f32x4*)(brp + 4), bi0 = *(const f32x4*)bip, bi1 = *(const f32x4*)(bip + 4);
        const f32x4 re0 = cfr * br0 - cfi * bi0, re1 = cfr * br1 - cfi * bi1, im0 = cfr * bi0 + cfi * br0, im1 = cfr * bi1 + cfi * br1;
        bm[half] = pack8v(re0, re1); bm[2 + half] = pack8v(im0, im1);
        lr[half] = er; li[half] = ei;
        const float r2 = er * er - ei * ei, i2 = 2.f * er * ei; l4r[half] = r2 * r2 - i2 * i2; l4i[half] = 2.f * r2 * i2;
    }
    float sr[2] = {0.f, 0.f}, si[2] = {0.f, 0.f};
    const int tok_base = b * 4096 + span * 256;
    bf16x8 ufa[8];
#pragma unroll
    for (int sub = 0; sub < 8; ++sub) ufa[sub] = *(const bf16x8*)(Hb + (size_t)(tok_base + sub * 32 + (lane & 31)) * 5120 + g * 16 + 8 * hh);
#pragma unroll
    for (int sub = 0; sub < 8; ++sub) {
        const bf16x8 uf = ufa[sub];
        f32x16 d[4];
#pragma unroll
        for (int ct = 0; ct < 4; ++ct) {
#pragma unroll
            for (int i = 0; i < 16; ++i) d[ct][i] = 0.f;
            d[ct] = MFMA32(uf, bm[ct], d[ct]);
        }
#pragma unroll
        for (int s = 0; s < 2; ++s) {
            float Er[8], Ei[8];
#pragma unroll
            for (int q = 0; q < 4; ++q) {
                float er = d[s][4 * q], ei = d[2 + s][4 * q];
#pragma unroll
                for (int j = 1; j < 4; ++j) { const float nr = lr[s] * er - li[s] * ei + d[s][4 * q + j], ni = lr[s] * ei + li[s] * er + d[2 + s][4 * q + j]; er = nr; ei = ni; }
                const unsigned ur = __builtin_bit_cast(unsigned, er), ui = __builtin_bit_cast(unsigned, ei);
                const auto xr = __builtin_amdgcn_permlane32_swap(ur, ur, false, false), xi = __builtin_amdgcn_permlane32_swap(ui, ui, false, false);
                Er[2 * q] = __builtin_bit_cast(float, xr[0]); Er[2 * q + 1] = __builtin_bit_cast(float, xr[1]);
                Ei[2 * q] = __builtin_bit_cast(float, xi[0]); Ei[2 * q + 1] = __builtin_bit_cast(float, xi[1]);
            }
#pragma unroll
            for (int blk = 0; blk < 8; ++blk) { const float nr = l4r[s] * sr[s] - l4i[s] * si[s] + Er[blk], ni = l4r[s] * si[s] + l4i[s] * sr[s] + Ei[blk]; sr[s] = nr; si[s] = ni; }
        }
    }
    float* E = a.states + ((size_t)(b * 16 + span) * 32 + g) * 128 + lane;
    E[0] = hh ? sr[1] : sr[0]; E[64] = hh ? si[1] : si[0];
}

DI void s5_out_task(const Args& a, LAS float* img, int b, int g, int span, int lane) {
    const float* lam_re = a.in[2]; const float* lam_im = a.in[3]; const float* log_dt = a.in[4];
    const float* b_re = a.in[5]; const float* b_im = a.in[6]; const float* c_re = a.in[7]; const float* c_im = a.in[8]; const float* dsk = a.in[9];
    const bf16_t* Hb = a.Hb;
    const float dt = expf(log_dt[g]);
    const int hh = lane >> 5, c = lane & 31;
    const int tok_base = b * 4096 + span * 256;
    bf16x8 ufa[8];
#pragma unroll
    for (int sub = 0; sub < 8; ++sub) ufa[sub] = *(const bf16x8*)(Hb + (size_t)(tok_base + sub * 32 + c) * 5120 + g * 16 + 8 * hh);
    float lbr, lbi;
    { const float lr = lam_re[g * 64 + lane], li = lam_im[g * 64 + lane]; const float mag = expf(lr * dt); lbr = mag * cosf(li * dt); lbi = mag * sinf(li * dt); }
    bf16x8 bm[4]; float pwr[2][4], pwi[2][4];
#pragma unroll
    for (int half = 0; half < 2; ++half) {
        const int n = 32 * half + c;
        const float lrn = lam_re[g * 64 + n], lin = lam_im[g * 64 + n]; const float mag = expf(lrn * dt);
        const float er = mag * cosf(lin * dt), ei = mag * sinf(lin * dt); const float den = lrn * lrn + lin * lin;
        const float cfr = ((er - 1.f) * lrn + ei * lin) / den, cfi = (ei * lrn - (er - 1.f) * lin) / den;
        const float* brp = b_re + (size_t)(g * 64 + n) * 16 + 8 * hh; const float* bip = b_im + (size_t)(g * 64 + n) * 16 + 8 * hh;
        const f32x4 br0 = *(const f32x4*)brp, br1 = *(const f32x4*)(brp + 4), bi0 = *(const f32x4*)bip, bi1 = *(const f32x4*)(bip + 4);
        const f32x4 re0 = cfr * br0 - cfi * bi0, re1 = cfr * br1 - cfi * bi1, im0 = cfr * bi0 + cfi * br0, im1 = cfr * bi1 + cfi * br1;
        bm[half] = pack8v(re0, re1); bm[2 + half] = pack8v(im0, im1);
        pwr[half][0] = er; pwi[half][0] = ei;
#pragma unroll
        for (int k = 1; k < 4; ++k) { pwr[half][k] = pwr[half][k - 1] * er - pwi[half][k - 1] * ei; pwi[half][k] = pwr[half][k - 1] * ei + pwi[half][k - 1] * er; }
    }
    const int kq = lane >> 4, hcol = lane & 15;
    bf16x8 cm[5];
#pragma unroll
    for (int ks = 0; ks < 4; ++ks) {
        const float* src = ((ks < 2) ? c_re : c_im) + (size_t)(g * 16 + hcol) * 64 + 32 * (ks & 1) + 8 * kq;
        f32x4 v0 = *(const f32x4*)src, v1 = *(const f32x4*)(src + 4);
        if (ks >= 2) { v0 = -v0; v1 = -v1; }
        cm[ks] = pack8v(v0, v1);
    }
    { const float dfull = dsk[g * 16 + hcol]; const float dhi = bflo(cvt_pk_bf16(dfull, 0.f) & 0xffffu); const float dv = (kq < 2) ? dhi : (dfull - dhi);
      f32x4 v0 = {0.f, 0.f, 0.f, 0.f}, v1 = {0.f, 0.f, 0.f, 0.f};
#pragma unroll
      for (int j = 0; j < 4; ++j) { v0[j] = (8 * (kq & 1) + j == hcol) ? dv : 0.f; v1[j] = (8 * (kq & 1) + 4 + j == hcol) ? dv : 0.f; }
      cm[4] = pack8v(v0, v1); }
    float sre = 0.f, sim = 0.f;
    if (span > 0) {
        float pr = lbr, pi = lbi;
#pragma unroll
        for (int i = 0; i < 8; ++i) { const float nr = pr * pr - pi * pi, ni = 2.f * pr * pi; pr = nr; pi = ni; }
        const float* E = a.states + ((size_t)(b * 16) * 32 + g) * 128 + lane;
        float er[15], ei[15];
#pragma unroll
        for (int sp = 0; sp < 15; ++sp) { const bool on = sp < span; er[sp] = on ? E[(size_t)sp * 32 * 128] : 0.f; ei[sp] = on ? E[(size_t)sp * 32 * 128 + 64] : 0.f; }
#pragma unroll
        for (int sp = 0; sp < 15; ++sp) if (sp < span) { const float nr = pr * sre - pi * sim + er[sp], ni = pr * sim + pi * sre + ei[sp]; sre = nr; sim = ni; }
    }
    float sr[2], si[2];
    { const unsigned ur = __builtin_bit_cast(unsigned, sre), ui = __builtin_bit_cast(unsigned, sim);
      const auto xr = __builtin_amdgcn_permlane32_swap(ur, ur, false, false), xi = __builtin_amdgcn_permlane32_swap(ui, ui, false, false);
      sr[0] = __builtin_bit_cast(float, xr[0]); sr[1] = __builtin_bit_cast(float, xr[1]); si[0] = __builtin_bit_cast(float, xi[0]); si[1] = __builtin_bit_cast(float, xi[1]); }
    const int bp0 = (32 * (kq & 1) + hcol) * 4;
#pragma nounroll
    for (int sub = 0; sub < 8; ++sub) {
        const int tok0 = tok_base + sub * 32;
        const bf16x8 ucur = ufa[0];
#pragma unroll
        for (int i = 0; i < 7; ++i) ufa[i] = ufa[i + 1];
        f32x16 d[4];
#pragma unroll
        for (int ct = 0; ct < 4; ++ct) {
#pragma unroll
            for (int i = 0; i < 16; ++i) d[ct][i] = 0.f;
            d[ct] = MFMA32(ucur, bm[ct], d[ct]);
        }
#pragma unroll
        for (int s = 0; s < 2; ++s) {
            float Er[8], Ei[8];
#pragma unroll
            for (int q = 0; q < 4; ++q) {
#pragma unroll
                for (int j = 1; j < 4; ++j) { const float pr_ = d[s][4 * q + j - 1], pi_ = d[2 + s][4 * q + j - 1];
                    d[s][4 * q + j] += pwr[s][0] * pr_ - pwi[s][0] * pi_; d[2 + s][4 * q + j] += pwr[s][0] * pi_ + pwi[s][0] * pr_; }
                const unsigned ur = __builtin_bit_cast(unsigned, d[s][4 * q + 3]), ui = __builtin_bit_cast(unsigned, d[2 + s][4 * q + 3]);
                const auto xr = __builtin_amdgcn_permlane32_swap(ur, ur, false, false), xi = __builtin_amdgcn_permlane32_swap(ui, ui, false, false);
                Er[2 * q] = __builtin_bit_cast(float, xr[0]); Er[2 * q + 1] = __builtin_bit_cast(float, xr[1]);
                Ei[2 * q] = __builtin_bit_cast(float, xi[0]); Ei[2 * q + 1] = __builtin_bit_cast(float, xi[1]);
            }
            float cr = sr[s], ci = si[s];
#pragma unroll
            for (int q = 0; q < 4; ++q) {
                const float c1r = pwr[s][3] * cr - pwi[s][3] * ci + Er[2 * q], c1i = pwr[s][3] * ci + pwi[s][3] * cr + Ei[2 * q];
                const float owr = hh ? c1r : cr, owi = hh ? c1i : ci;
#pragma unroll
                for (int j = 0; j < 4; ++j) { d[s][4 * q + j] += pwr[s][j] * owr - pwi[s][j] * owi; d[2 + s][4 * q + j] += pwr[s][j] * owi + pwi[s][j] * owr; }
                cr = pwr[s][3] * c1r - pwi[s][3] * c1i + Er[2 * q + 1]; ci = pwr[s][3] * c1i + pwi[s][3] * c1r + Ei[2 * q + 1];
            }
            sr[s] = cr; si[s] = ci;
#pragma unroll
            for (int q = 0; q < 4; ++q)
#pragma unroll
                for (int j = 0; j < 4; ++j) { const int t = 8 * q + 4 * hh + j; img[t * S5_PITCH + 32 * s + c] = d[s][4 * q + j]; img[t * S5_PITCH + 64 + 32 * s + c] = d[2 + s][4 * q + j]; }
        }
        bf16x8 ua[2];
        { const u32x4 uw = __builtin_bit_cast(u32x4, ucur);
#pragma unroll
          for (int tt = 0; tt < 2; ++tt) { u32x4 r;
              r.x = (unsigned)__builtin_amdgcn_ds_bpermute(bp0 + 64 * tt, (int)uw.x); r.y = (unsigned)__builtin_amdgcn_ds_bpermute(bp0 + 64 * tt, (int)uw.y);
              r.z = (unsigned)__builtin_amdgcn_ds_bpermute(bp0 + 64 * tt, (int)uw.z); r.w = (unsigned)__builtin_amdgcn_ds_bpermute(bp0 + 64 * tt, (int)uw.w);
              ua[tt] = __builtin_bit_cast(bf16x8, r); } }
        LDS_WAIT(); asm volatile("" ::: "memory");
#pragma unroll
        for (int tt = 0; tt < 2; ++tt) {
            f32x4 y = {0.f, 0.f, 0.f, 0.f};
#pragma unroll
            for (int ks = 0; ks < 4; ++ks) {
                const LAS float* sp = img + (16 * tt + hcol) * S5_PITCH + 32 * ks + 8 * kq;
                const f32x4 s0 = *(const LAS f32x4*)sp, s1 = *(const LAS f32x4*)(sp + 4);
                y = MFMA16(pack8v(s0, s1), cm[ks], y);
            }
            y = MFMA16(ua[tt], cm[4], y);
#pragma unroll
            for (int i = 0; i < 4; ++i) {
                const size_t tok = (size_t)(tok0 + 16 * tt + 4 * kq + i);
                const float v = y[i];
                const float aa = 0.7978845608028654f * (v + 0.044715f * v * v * v);
                const float gl = v * __builtin_amdgcn_rcpf(1.f + __expf(-2.f * aa));
                a.Gs[tok * 512 + g * 16 + hcol] = (bf16_t)(cvt_pk_bf16(gl, 0.f) & 0xffffu);
            }
        }
        LDS_WAIT(); asm volatile("" ::: "memory");
    }
}

struct Frame { LAS unsigned char* lds; volatile LAS unsigned* MISC; int tid, lane, wave, G, gw, NGW; };

DI float wave_sum(float v) {
#pragma unroll
    for (int o = 1; o < 64; o <<= 1) v += __shfl_xor(v, o);
    return v;
}

constexpr float ALPHA_F = 1.41421356237309515f, LN_EPS_F = 1e-5f;
DI void ln_stats32(float (&v)[32], float& mean, float& rstd) {
    float s = 0.f;
#pragma unroll
    for (int i = 0; i < 32; i += 4) s += (v[i] + v[i + 1]) + (v[i + 2] + v[i + 3]);
    mean = wave_sum(s) * (1.f / 2048.f);
    float q = 0.f;
#pragma unroll
    for (int i = 0; i < 32; i += 4) { v[i] -= mean; v[i + 1] -= mean; v[i + 2] -= mean; v[i + 3] -= mean; q += (v[i] * v[i] + v[i + 1] * v[i + 1]) + (v[i + 2] * v[i + 2] + v[i + 3] * v[i + 3]); }
    rstd = 1.f / sqrtf(wave_sum(q) * (1.f / 2048.f) + LN_EPS_F);
}
DI void up8a(const u32x4 x, float* f) { f[0] = bflo(x.x); f[1] = bfhi(x.x); f[2] = bflo(x.y); f[3] = bfhi(x.y); f[4] = bflo(x.z); f[5] = bfhi(x.z); f[6] = bflo(x.w); f[7] = bfhi(x.w); }

struct Ln1Row { u32x4 pre[4]; };
DI void ln1_load(Ln1Row& R, const bf16_t* Pre, size_t row, int lane) {
#pragma unroll
    for (int j = 0; j < 4; ++j) R.pre[j] = *(const u32x4*)(Pre + row * 2048 + 512 * j + 8 * lane);
}
DI void ln1_tables(const Frame& F, const float* lg, const float* lb, const float* rw, const float* rb, unsigned char* gt, int w0) {
    u32x4* GHg = (u32x4*)gt; u32x4* GLg = GHg + 4096; float* SBg = (float*)(gt + 131072);
    for (int it = (F.gw - w0) * 64 + F.lane; it >= 0 && it < 4096; it += 4096) { const int o = it >> 4, e = it & 15, c0 = 8 * o;
        const f32x4 g0 = *(const f32x4*)(lg + c0), g1 = *(const f32x4*)(lg + c0 + 4);
        float G[8];
#pragma unroll
        for (int j = 0; j < 8; ++j) G[j] = (j < 4 ? g0[j] : g1[j - 4]) * rw[(size_t)(c0 + j) * 16 + e];
        u32x4 hi, lo; float r[8];
        hi.x = cvt_pk_bf16(G[0], G[1]); hi.y = cvt_pk_bf16(G[2], G[3]); hi.z = cvt_pk_bf16(G[4], G[5]); hi.w = cvt_pk_bf16(G[6], G[7]);
        r[0] = G[0] - bflo(hi.x); r[1] = G[1] - bfhi(hi.x); r[2] = G[2] - bflo(hi.y); r[3] = G[3] - bfhi(hi.y); r[4] = G[4] - bflo(hi.z); r[5] = G[5] - bfhi(hi.z); r[6] = G[6] - bflo(hi.w); r[7] = G[7] - bfhi(hi.w);
        lo.x = cvt_pk_bf16(r[0], r[1]); lo.y = cvt_pk_bf16(r[2], r[3]); lo.z = cvt_pk_bf16(r[4], r[5]); lo.w = cvt_pk_bf16(r[6], r[7]);
        GHg[it] = hi; GLg[it] = lo;
    }
    const int t = F.gw - w0 - 64;
    if (t >= 0 && t < 16) { float ps = 0.f, pb = 0.f;
        for (int c = F.lane; c < 2048; c += 64) { const float w = rw[(size_t)c * 16 + t]; ps += lg[c] * w; pb += lb[c] * w; }
        ps = wave_sum(ps); pb = wave_sum(pb);
        if (F.lane == 0) { SBg[t] = ps; SBg[16 + t] = pb + rb[t]; } }
}
constexpr int LN1_LOGIT_OFF = 131072;
DI void ln1_router_phase(const Frame& F, const bf16_t* Pre, const float* lg, const float* lb, const unsigned char* gtab,
                         bf16_t* h1, float* gates, int* cnt, int* tok_list, int* crow_list) {
    LAS u32x4* GH = (LAS u32x4*)F.lds; LAS u32x4* GL = GH + 4096;
    LAS float* LT = (LAS float*)(F.lds + LN1_LOGIT_OFF); LAS float* SB = LT + 1024; LAS float* PD = SB + 32; LAS float* ST = PD + 1024;
    volatile LAS int* lcnt = (volatile LAS int*)(F.MISC + 64); volatile LAS int* lbase = (volatile LAS int*)(F.MISC + 80);
    {
        const u32x4* src = (const u32x4*)gtab;
#pragma unroll
        for (int k = 0; k < 16; ++k) {
            const int chunk = (k * NWAVES + F.wave) * 64;
            __builtin_amdgcn_global_load_lds((const unsigned*)(src + chunk + F.lane), (LAS unsigned*)(GH + chunk), 16, 0, 0); }
        asm volatile("s_waitcnt vmcnt(0)" ::: "memory");
        if (F.tid < 32) SB[F.tid] = ((const float*)(gtab + 131072))[F.tid];
    }
    for (int rb0 = blockIdx.x * 64; rb0 < 16384; rb0 += F.G * 64) {
        if (F.tid < 16) lcnt[F.tid] = 0;
        __syncthreads();
        {
            const int grp = F.wave & 3, half = F.wave >> 2, r = F.lane & 15, kq = F.lane >> 4;
            const bf16_t* arow = Pre + (size_t)(rb0 + 16 * grp + r) * 2048 + 1024 * half + 8 * kq;
            f32x4 D = {0.f, 0.f, 0.f, 0.f}; float sx = 0.f, sxx = 0.f;
#pragma nounroll
            for (int s = 0; s < 32; s += 8) {
                bf16x8 av[8];
#pragma unroll
                for (int u = 0; u < 8; ++u) av[u] = *(const bf16x8*)(arow + 32 * (s + u));
#pragma unroll
                for (int u = 0; u < 8; ++u) { const int o = (32 * half + s + u) * 4 + kq;
                    const u32x4 gh = GH[o * 16 + r], gl = GL[o * 16 + r];
                    D = MFMA16(av[u], __builtin_bit_cast(bf16x8, gh), D); D = MFMA16(av[u], __builtin_bit_cast(bf16x8, gl), D);
                    float x[8]; up8a(__builtin_bit_cast(u32x4, av[u]), x);
#pragma unroll
                    for (int j = 0; j < 8; ++j) { sx += x[j]; sxx += x[j] * x[j]; } }
            }
            sx += __shfl_xor(sx, 16); sx += __shfl_xor(sx, 32); sxx += __shfl_xor(sxx, 16); sxx += __shfl_xor(sxx, 32);
            if (kq == 0) { ST[((half * 4 + grp) * 16 + r) * 2] = sx; ST[((half * 4 + grp) * 16 + r) * 2 + 1] = sxx; }
            if (half == 1) {
#pragma unroll
                for (int i = 0; i < 4; ++i) PD[(grp * 16 + 4 * kq + i) * 16 + r] = D[i]; }
            __syncthreads();
            if (half == 0) {
#pragma unroll
                for (int i = 0; i < 4; ++i) { const int row = 4 * kq + i;
                    const float s1 = ST[(grp * 16 + row) * 2] + ST[((4 + grp) * 16 + row) * 2], s2 = ST[(grp * 16 + row) * 2 + 1] + ST[((4 + grp) * 16 + row) * 2 + 1];
                    const float mean = s1 * (1.f / 2048.f), var = s2 * (1.f / 2048.f) - mean * mean, rstd = 1.f / sqrtf(var + LN_EPS_F);
                    LT[(16 * grp + row) * 16 + r] = rstd * (D[i] + PD[(grp * 16 + row) * 16 + r] - mean * SB[r]) + SB[16 + r]; }
            }
        }
        Ln1Row nx; ln1_load(nx, Pre, (size_t)(rb0 + F.wave * 8), F.lane);
        for (int i = 0; i < 8; ++i) {
            const int lr = F.wave * 8 + i; const size_t row = (size_t)(rb0 + lr);
            float v[32];
#pragma unroll
            for (int j = 0; j < 4; ++j) up8a(nx.pre[j], &v[8 * j]);
            if (i < 7) ln1_load(nx, Pre, row + 1, F.lane);
            const int sg = (lr >> 4) * 16 + (lr & 15);
            const float s1 = ST[sg * 2] + ST[(64 + sg) * 2], s2 = ST[sg * 2 + 1] + ST[(64 + sg) * 2 + 1];
            const float mean = s1 * (1.f / 2048.f), rstd = 1.f / sqrtf(s2 * (1.f / 2048.f) - mean * mean + LN_EPS_F);
#pragma unroll
            for (int j = 0; j < 4; ++j) {
                const int cb = 512 * j + 8 * F.lane;
                const f32x4 ga = *(const f32x4*)(lg + cb), gb = *(const f32x4*)(lg + cb + 4), ba = *(const f32x4*)(lb + cb), bb = *(const f32x4*)(lb + cb + 4);
#pragma unroll
                for (int q = 0; q < 4; ++q) { v[8 * j + q] = (v[8 * j + q] - mean) * rstd * ga[q] + ba[q]; v[8 * j + 4 + q] = (v[8 * j + 4 + q] - mean) * rstd * gb[q] + bb[q]; }
                u32x4 w; w.x = cvt_pk_bf16(v[8 * j], v[8 * j + 1]); w.y = cvt_pk_bf16(v[8 * j + 2], v[8 * j + 3]); w.z = cvt_pk_bf16(v[8 * j + 4], v[8 * j + 5]); w.w = cvt_pk_bf16(v[8 * j + 6], v[8 * j + 7]);
                *(u32x4*)(h1 + row * 2048 + cb) = w;
            }
        }
        __syncthreads();
        if (F.wave == 0) {
            const int lr = F.lane; const size_t row = (size_t)(rb0 + lr);
            float p[16];
#pragma unroll
            for (int e4 = 0; e4 < 4; ++e4) { const f32x4 t = *(const LAS f32x4*)(LT + lr * 16 + 4 * e4); p[4 * e4] = t[0]; p[4 * e4 + 1] = t[1]; p[4 * e4 + 2] = t[2]; p[4 * e4 + 3] = t[3]; }
            float mx = p[0];
#pragma unroll
            for (int e = 1; e < 16; ++e) mx = fmaxf(mx, p[e]);
#pragma unroll
            for (int e = 0; e < 16; ++e) p[e] = expf(p[e] - mx);
            int gsel = 0; float best = -1.f;
#pragma unroll
            for (int gi = 0; gi < 4; ++gi) {
                float m1 = -1.f, m2 = -1.f;
#pragma unroll
                for (int jj = 0; jj < 4; ++jj) { const float pv = p[gi * 4 + jj]; if (pv > m1) { m2 = m1; m1 = pv; } else if (pv > m2) m2 = pv; }
                const float sc = m1 + m2;
                if (sc > best) { best = sc; gsel = gi; }
            }
            int i1 = 0, i2 = 0; float m1 = -1.f, m2 = -1.f;
#pragma unroll
            for (int e = 0; e < 16; ++e) if ((e >> 2) == gsel) { const float pv = p[e]; if (pv > m1) { m2 = m1; i2 = i1; m1 = pv; i1 = e; } else if (pv > m2) { m2 = pv; i2 = e; } }
            const float den = m1 + m2;
            gates[2 * row] = m1 / den; gates[2 * row + 1] = m2 / den;
            const int s1 = __hip_atomic_fetch_add((LAS int*)&lcnt[i1], 1, __ATOMIC_RELAXED, __HIP_MEMORY_SCOPE_WORKGROUP);
            const int s2 = __hip_atomic_fetch_add((LAS int*)&lcnt[i2], 1, __ATOMIC_RELAXED, __HIP_MEMORY_SCOPE_WORKGROUP);
            LDS_WAIT(); asm volatile("" ::: "memory");
            if (F.lane < 16) lbase[F.lane] = atomicAdd(&cnt[F.lane], lcnt[F.lane]);
            LDS_WAIT(); asm volatile("" ::: "memory");
            const int tok = rb0 + lr;
            const int d1 = lbase[i1] + s1, d2 = lbase[i2] + s2;
            tok_list[i1 * 16384 + d1] = tok; crow_list[i1 * 16384 + d1] = tok;
            tok_list[i2 * 16384 + d2] = tok; crow_list[i2 * 16384 + d2] = 16384 + tok;
        }
        __syncthreads();
    }
}

struct Ln2Row { u32x4 h[4], a[4], b[4]; float g0, g1; };
DI void ln2_load(Ln2Row& R, const bf16_t* h1, const bf16_t* ffn, const float* gates, size_t row, int lane) {
#pragma unroll
    for (int j = 0; j < 4; ++j) { const size_t o = row * 2048 + 512 * j + 8 * lane;
        R.h[j] = *(const u32x4*)(h1 + o); R.a[j] = *(const u32x4*)(ffn + o); R.b[j] = *(const u32x4*)(ffn + (size_t)16384 * 2048 + o); }
    R.g0 = gates[2 * row]; R.g1 = gates[2 * row + 1];
}
template <bool OUT_F32>
DI void ln2_phase(const Frame& F, const bf16_t* h1, const bf16_t* ffn, const float* gates, const float* lg, const float* lb, void* outp) {
    f32x4 gv[8], bv[8];
#pragma unroll
    for (int j = 0; j < 4; ++j) { const int cb = 512 * j + 8 * F.lane; gv[2 * j] = *(const f32x4*)(lg + cb); gv[2 * j + 1] = *(const f32x4*)(lg + cb + 4); bv[2 * j] = *(const f32x4*)(lb + cb); bv[2 * j + 1] = *(const f32x4*)(lb + cb + 4); }
    Ln2Row nx; ln2_load(nx, h1, ffn, gates, (size_t)F.gw, F.lane);
    for (int r = F.gw; r < 16384; r += F.NGW) {
        const size_t row = (size_t)r;
        float v[32];
#pragma unroll
        for (int j = 0; j < 4; ++j) { float x[8], y[8], z[8]; up8a(nx.h[j], x); up8a(nx.a[j], y); up8a(nx.b[j], z);
#pragma unroll
            for (int q = 0; q < 8; ++q) v[8 * j + q] = ALPHA_F * x[q] + nx.g0 * y[q] + nx.g1 * z[q]; }
        if (r + F.NGW < 16384) ln2_load(nx, h1, ffn, gates, (size_t)(r + F.NGW), F.lane);
        float mean, rstd; ln_stats32(v, mean, rstd);
#pragma unroll
        for (int j = 0; j < 4; ++j) {
#pragma unroll
            for (int q = 0; q < 4; ++q) { v[8 * j + q] = v[8 * j + q] * rstd * gv[2 * j][q] + bv[2 * j][q]; v[8 * j + 4 + q] = v[8 * j + 4 + q] * rstd * gv[2 * j + 1][q] + bv[2 * j + 1][q]; }
            const size_t o = row * 2048 + 512 * j + 8 * F.lane;
            if (OUT_F32) { *(f32x4*)((float*)outp + o) = (f32x4){v[8 * j], v[8 * j + 1], v[8 * j + 2], v[8 * j + 3]}; *(f32x4*)((float*)outp + o + 4) = (f32x4){v[8 * j + 4], v[8 * j + 5], v[8 * j + 6], v[8 * j + 7]}; }
            else { u32x4 w; w.x = cvt_pk_bf16(v[8 * j], v[8 * j + 1]); w.y = cvt_pk_bf16(v[8 * j + 2], v[8 * j + 3]); w.z = cvt_pk_bf16(v[8 * j + 4], v[8 * j + 5]); w.w = cvt_pk_bf16(v[8 * j + 6], v[8 * j + 7]);
                *(u32x4*)((bf16_t*)outp + o) = w; }
        }
    }
}

DI void up8(const u32x4 x, float (&f)[8]) { f[0] = bflo(x.x); f[1] = bfhi(x.x); f[2] = bflo(x.y); f[3] = bfhi(x.y); f[4] = bflo(x.z); f[5] = bfhi(x.z); f[6] = bflo(x.w); f[7] = bfhi(x.w); }
template <int W> DI void pool_load(const bf16_t* __restrict__ Hc, size_t rowbase, int t0, int col, u32x4 (&x)[W + 7]) {
#pragma unroll
    for (int q = 0; q < W + 7; ++q) { const int t = t0 - (W - 1) + q;
        x[q] = (t >= 0) ? *(const u32x4*)(Hc + (rowbase + (size_t)(t >= 0 ? t : 0)) * 2048 + col) : (u32x4){0u, 0u, 0u, 0u}; }
}
template <int W> DI void pool_store(bf16_t* __restrict__ Pl, size_t rowbase, int t0, int col, const u32x4 (&x)[W + 7]) {
    float s[8];
#pragma unroll
    for (int c = 0; c < 8; ++c) s[c] = 0.f;
#pragma unroll
    for (int q = 0; q < W; ++q) { float f[8]; up8(x[q], f);
#pragma unroll
        for (int c = 0; c < 8; ++c) s[c] += f[c]; }
#pragma unroll
    for (int i = 0; i < 8; ++i) {
        const int t = t0 + i; const float inv = 1.f / (float)((t + 1) < W ? (t + 1) : W);
        float f[8]; up8(x[W - 1 + i], f);
        u32x4 o; o.x = cvt_pk_bf16(s[0] * inv - f[0], s[1] * inv - f[1]); o.y = cvt_pk_bf16(s[2] * inv - f[2], s[3] * inv - f[3]);
        o.z = cvt_pk_bf16(s[4] * inv - f[4], s[5] * inv - f[5]); o.w = cvt_pk_bf16(s[6] * inv - f[6], s[7] * inv - f[7]);
        *(u32x4*)(Pl + (rowbase + (size_t)t) * 2048 + col) = o;
        if (i < 7) { float a[8], d[8]; up8(x[W + i], a); up8(x[i], d);
#pragma unroll
            for (int c = 0; c < 8; ++c) s[c] += a[c] - d[c]; }
    }
}
DI void pool_phase(const Frame& F, const bf16_t* __restrict__ Hc, bf16_t* __restrict__ Pl) {
    for (int tb = F.gw; tb < 2048; tb += F.NGW) {
        const int tok0 = tb * 8; const size_t rowbase = (size_t)(tok0 & ~4095); const int t0 = tok0 & 4095; const int col = 8 * F.lane;
        { u32x4 xa[2 + 7], xb[4 + 7]; pool_load<2>(Hc, rowbase, t0, col, xa); pool_load<4>(Hc, rowbase, t0, 512 + col, xb);
          pool_store<2>(Pl, rowbase, t0, col, xa); pool_store<4>(Pl, rowbase, t0, 512 + col, xb); }
        { u32x4 xc[8 + 7], xd[16 + 7]; pool_load<8>(Hc, rowbase, t0, 1024 + col, xc); pool_load<16>(Hc, rowbase, t0, 1536 + col, xd);
          pool_store<8>(Pl, rowbase, t0, 1024 + col, xc); pool_store<16>(Pl, rowbase, t0, 1536 + col, xd); }
    }
}

constexpr int MOE0_QA = 9216, MOE0_QP4 = 9216;
constexpr int P3_NCV = 36;
struct ConvItem { const float* src; bf16_t* dst; int N, K, il, nb; };
DI void conv_load(const ConvItem& c, f32x4 (&t)[16]) {
#pragma unroll
    for (int p = 0; p < 16; ++p) t[p] = __builtin_nontemporal_load((const f32x4*)(c.src + (size_t)(4 * p) * c.N));
}
DI void conv_store(const ConvItem& c, const f32x4 (&t)[16], LAS float* scr, int lane) {
    const int c4 = lane & 15;
#pragma unroll
    for (int p = 0; p < 16; ++p) { const int kk = 4 * p + (lane >> 4); *(LAS f32x4*)(scr + kk * 68 + ((4 * c4) ^ (((kk >> 3) & 7) << 2))) = t[p]; }
    LDS_WAIT(); asm volatile("" ::: "memory");
    const int c8 = lane & 7;
#pragma unroll
    for (int pp = 0; pp < 8; ++pp) { const int n = 8 * pp + (lane >> 3); const LAS float* s = scr + (8 * c8) * 68 + (n ^ (c8 << 2));
        u32x4 o; o.x = pk2(s[0 * 68], s[1 * 68]); o.y = pk2(s[2 * 68], s[3 * 68]); o.z = pk2(s[4 * 68], s[5 * 68]); o.w = pk2(s[6 * 68], s[7 * 68]);
        const int j = 64 * c.nb + n; const int drow = c.il ? ((j >> 4) * 32 + (c.il - 1) * 16 + (j & 15)) : j;
        *(u32x4*)(c.dst + (size_t)drow * c.K + 8 * c8) = o; }
    LDS_WAIT(); asm volatile("" ::: "memory");
}
DI ConvItem conv_item(const float* W0, const float* W1, int N, int K, bf16_t* WT, int il, int kb, int nb, int lane) {
    const int c4 = lane & 15; ConvItem c;
    c.src = ((il == 2 ? W1 : W0) + 64 * nb + 4 * c4) + (size_t)(64 * kb + (lane >> 4)) * N;
    c.dst = WT + 64 * kb; c.N = N; c.K = K; c.il = il; c.nb = nb; return c;
}
DI ConvItem moe_item(const Args& a, int l, int it, int lane) {
    if (it < 16384) { const int e = it >> 10, r = it & 1023; const size_t so = ((size_t)l * 16 + e) * 2048 * 1024;
        return conv_item(a.in[21] + so, a.in[22] + so, 1024, 2048, a.Wt_gu + ((size_t)l * 16 + e) * 2048 * 2048, 1 + ((r >> 4) & 1), r >> 5, r & 15, lane); }
    const int i2 = it - 16384, e = i2 >> 9, r = i2 & 511; const size_t so = ((size_t)l * 16 + e) * 1024 * 2048;
    return conv_item(a.in[23] + so, nullptr, 2048, 1024, a.Wt_dn + ((size_t)l * 16 + e) * 2048 * 1024, 0, r >> 5, r & 31, lane);
}
DI void moe_convert_range(const Frame& F, const Args& a, int l, int lo, int hi, int widx, int nw) {
    LAS float* scr = (LAS float*)(F.lds + F.wave * WSCR);
    int it = lo + widx; if (it >= hi) return;
    ConvItem cur = moe_item(a, l, it, F.lane); f32x4 t[16]; conv_load(cur, t);
    for (;;) {
        const int nx = it + nw; const bool more = nx < hi;
        ConvItem nxt = cur; f32x4 tn[16];
        if (more) { nxt = moe_item(a, l, nx, F.lane); conv_load(nxt, tn); }
        conv_store(cur, t, scr, F.lane);
        if (!more) break;
#pragma unroll
        for (int p = 0; p < 16; ++p) t[p] = tn[p];
        cur = nxt; it = nx;
    }
}
DI void conv_plain(const Frame& F, const float* W, int K, int N, bf16_t* WT, int widx = -1, int nw = 0) {
    LAS float* scr = (LAS float*)(F.lds + F.wave * WSCR);
    const int nnb = N / 64, nit = (K / 64) * nnb;
    if (widx < 0) { widx = F.gw; nw = F.NGW; }
    for (int it = widx; it < nit; it += nw) { const ConvItem c = conv_item(W, nullptr, N, K, WT, 0, it / nnb, it % nnb, F.lane); f32x4 t[16]; conv_load(c, t); conv_store(c, t, scr, F.lane); }
}
DI void p0_convert(const Frame& F, const Args& a) {
    const int m = a.cmask;
    if (m & 1) {
        const size_t n8 = (size_t)16384 * 2048 / 8, stride = (size_t)F.NGW * 64;
        for (size_t i = (size_t)F.gw * 64 + F.lane; i < n8; i += 4 * stride) {
            f32x4 v[4][2];
#pragma unroll
            for (int u = 0; u < 4; ++u) { const size_t j = i + u * stride; if (j < n8) { v[u][0] = __builtin_nontemporal_load((const f32x4*)(a.in[0] + j * 8)); v[u][1] = __builtin_nontemporal_load((const f32x4*)(a.in[0] + j * 8 + 4)); } }
#pragma unroll
            for (int u = 0; u < 4; ++u) { const size_t j = i + u * stride; if (j < n8) {
                u32x4 o; o.x = pk2(v[u][0][0], v[u][0][1]); o.y = pk2(v[u][0][2], v[u][0][3]); o.z = pk2(v[u][1][0], v[u][1][1]); o.w = pk2(v[u][1][2], v[u][1][3]);
                *(u32x4*)(a.xb + j * 8) = o; } }
        }
    }
    if (m & 2) conv_plain(F, a.in[1], 2048, 5120, a.Wt_in);
    if (m & 4) { if (!(m & 256)) conv_plain(F, a.in[12], 2048, 2048, a.Wt_out); conv_plain(F, a.in[10], 512, 512, a.Wt_glu); }
    if (m & 8) { ln1_tables(F, a.in[17], a.in[18], a.in[19], a.in[20], a.ws + 5 * MiB, 0); ln1_tables(F, a.in[17] + 2 * 2048, a.in[18] + 2 * 2048, a.in[19], a.in[20], a.ws + 5 * MiB + 262144, 128);
        if (!(m & 256)) conv_plain(F, a.in[16], 2048, 2048, a.Wt_cout);
        for (size_t i = (size_t)F.gw * 64 + F.lane; i < (size_t)2048 * 2048 / 8; i += (size_t)F.NGW * 64) {
            const f32x4 v0 = *(const f32x4*)(a.in[13] + i * 8), v1 = *(const f32x4*)(a.in[13] + i * 8 + 4);
            u32x4 o; o.x = pk2(v0[0], v0[1]); o.y = pk2(v0[2], v0[3]); o.z = pk2(v1[0], v1[1]); o.w = pk2(v1[2], v1[3]);
            *(u32x4*)(a.Wcin_b + i * 8) = o; }
        for (int g = 0; g < 4; ++g) conv_plain(F, a.in[14] + (size_t)g * 512 * 512, 512, 512, a.Wt_cgrp + (size_t)g * 512 * 512); }
    if (m & 16) moe_convert_range(F, a, 0, 0, (m & 128) ? ((F.G * NWAVES == 2048 ? MOE0_QA - 256 * P3_NCV : MOE0_QA)) : 24576, F.gw, F.NGW);
    if (m & 32) moe_convert_range(F, a, 1, 0, 24576, F.gw, F.NGW);
}

DI void moe1_convert_range(const Frame& F, const Args& a, int lo, int hi, int widx, int nw) { moe_convert_range(F, a, 1, lo, hi, widx, nw); }
constexpr int MOE1_Q1 = 12500, MOE1_Q2 = 16384, MOE1_NIT = 24576;

__global__ void __launch_bounds__(NWAVES * 64, 2) mega(Args args_by_value) {
    const Args& args = *(const Args*)__builtin_amdgcn_kernarg_segment_ptr();
    extern __shared__ __attribute__((aligned(16))) unsigned char lds_raw[];
    Frame F;
    F.lds = (LAS unsigned char*)lds_raw;
    F.MISC = (volatile LAS unsigned*)(F.lds + MISC_OFF);
    F.tid = threadIdx.x; F.lane = F.tid & 63; F.wave = __builtin_amdgcn_readfirstlane(F.tid >> 6);
    F.G = gridDim.x; F.gw = blockIdx.x * NWAVES + F.wave; F.NGW = F.G * NWAVES;
    for (int u = F.tid; u < (LDS_BYTES - MISC_OFF) / 4; u += NWAVES * 64) ((LAS unsigned*)(F.lds + MISC_OFF))[u] = 0u;
    __syncthreads();
    const int lo = args.ph_lo, hi = args.ph_hi;
    XcdBarrier bar; bar.bar = args.bar; bar.x = 0; bar.st = nullptr;
    if (hi - lo > 1) bar = xcd_barrier_post(args.bar, F.MISC + 8);
#define REFRAME() do { int t_ = threadIdx.x; asm volatile("" : "+v"(t_)); F.tid = t_; F.lane = t_ & 63; F.wave = __builtin_amdgcn_readfirstlane(t_ >> 6); F.gw = blockIdx.x * NWAVES + F.wave; } while (0)
#define IN(k) (lo <= (k) && (k) < hi)
#define SEAM(k) do { if (IN(k) && IN((k) + 1)) xcd_barrier(bar); } while (0)

    if (IN(0)) { REFRAME(); p0_convert(F, args); } SEAM(0);
    if (IN(1)) { REFRAME();
        const int G1 = ((args.cmask & 128) && MOE0_QA < 24576) ? (F.G >= 256 ? 216 : F.G) : F.G;
        if ((int)blockIdx.x < G1) {
            fg::PlainSched S{(const char*)args.xb, (const char*)args.Wt_in, 2048, 2048, 64, 20, G1, (int)blockIdx.x, 1 << 30, 0};
            fg::EpiBf16<0> E{args.Hb, 5120, nullptr, nullptr, 0};
            fg::gemm_phase<fg::EpiBf16<0>, fg::PlainSched, false>(F.lds, 2048, 2048, 2048, S, E);
        }
        if (args.cmask & 128) { if (G1 < F.G) { if ((int)blockIdx.x >= G1) moe_convert_range(F, args, 0, MOE0_QA, 24576, ((int)blockIdx.x - G1) * NWAVES + F.wave, (F.G - G1) * NWAVES); }
                                else moe_convert_range(F, args, 0, MOE0_QA, 24576, F.gw, F.NGW); }
    } SEAM(1);
    if (IN(2)) { REFRAME();
        for (int tk = F.gw; tk < 2048; tk += F.NGW) s5_end_task(args, tk >> 9, (tk >> 4) & 31, tk & 15, F.lane);
    } SEAM(2);
    if (IN(3)) { REFRAME();
        if (F.tid == 0) F.MISC[50] = 0u;
        __syncthreads();
        if (F.G * NWAVES == 2048) {
            if (F.wave < 4) for (int j = 0; j < 2; ++j) { const int tk = (int)blockIdx.x * 8 + F.wave + 4 * j; s5_out_task(args, (LAS float*)(F.lds + F.wave * WSCR), tk >> 9, (tk >> 4) & 31, tk & 15, F.lane); }
            for (;;) { int tq = 0; if (F.lane == 0) tq = __hip_atomic_fetch_add((LAS int*)(F.MISC + 50), 1, __ATOMIC_RELAXED, __HIP_MEMORY_SCOPE_WORKGROUP);
                tq = __builtin_amdgcn_readfirstlane(tq); if (tq >= 24 + P3_NCV / 4) break;
                { constexpr int NC = P3_NCV / 4, R = (24 + NC) / NC; const int cq = tq / R; if (tq % R == R - 1 && cq < NC) tq = 24 + cq; else { const int nb = (tq + 1) / R; tq -= nb < NC ? nb : NC; } }
                if (tq < 24) { const int it = (int)blockIdx.x * 8 + (tq & 7) + 2048 * (tq >> 3); const int qb = 127 - (it % 128), h = (it / 128) % 12, b = it / 1536;
                    attn_task(args.Hb, args.Ycat, 2048, 512, F.lds + F.wave * WSCR, b, h, qb, F.lane); }
                else { const int i0 = MOE0_QA - 256 * P3_NCV + (int)blockIdx.x * P3_NCV + 4 * (tq - 24); moe_convert_range(F, args, 0, i0, i0 + 4, 0, 1); } }
        } else {
        for (int tk = F.gw; tk < 2048; tk += F.NGW) s5_out_task(args, (LAS float*)(F.lds + F.wave * WSCR), tk >> 9, (tk >> 4) & 31, tk & 15, F.lane);
        for (int it = F.gw; it < 4 * 12 * 128; it += F.NGW) { const int qb = 127 - (it % 128), h = (it / 128) % 12, b = it / 1536;
            attn_task(args.Hb, args.Ycat, 2048, 512, F.lds + F.wave * WSCR, b, h, qb, F.lane); }
        }
    } SEAM(3);
    asm volatile(".fill %0, 4, 0xBF800000" :: "n"(CODE_SHIFT_DWORDS));
    if (IN(4)) { REFRAME();
        fg::PlainSched S{(const char*)args.Gs, (const char*)args.Wt_glu, 512, 512, 64, 2, F.G, (int)blockIdx.x, 1 << 30, 0};
        fg::EpiBf16<2> E{args.Ycat, 2048, args.in[11], args.Gs, 512};
        fg::gemm_phase<fg::EpiBf16<2>, fg::PlainSched, false>(F.lds, 512, 512, 512, S, E);
        if ((args.cmask & 256) && (int)blockIdx.x >= 192) {
            const int widx = ((int)blockIdx.x - 192) * NWAVES + F.wave, nw = (F.G - 192) * NWAVES;
            conv_plain(F, args.in[12], 2048, 2048, args.Wt_out, widx, nw); conv_plain(F, args.in[16], 2048, 2048, args.Wt_cout, widx, nw);
            moe_convert_range(F, args, 0, MOE0_QP4, MOE0_QA, widx, nw);
        }
        if ((int)blockIdx.x >= 128 && (int)blockIdx.x < 192) {
            fg::FoldSched S2{(const char*)args.Wt_cgrp, (const char*)args.Wcin_b, (int)blockIdx.x - 128};
            fg::EpiBf16<3> E2{args.Wt_cin, 2048, args.in[15], nullptr, 0};
            fg::gemm_phase<fg::EpiBf16<3>, fg::FoldSched, false>(F.lds, 512, 2048, 512, S2, E2);
        }
    } SEAM(4);
    if (IN(5)) { REFRAME();
        fg::PlainSched S{(const char*)args.Ycat, (const char*)args.Wt_out, 2048, 2048, 64, 8, F.G, (int)blockIdx.x, 1 << 30, 0};
        fg::EpiBf16<4> E{args.Pre, 2048, nullptr, args.xb, 2048};
        fg::gemm_phase<fg::EpiBf16<4>, fg::PlainSched, false>(F.lds, 2048, 2048, 2048, S, E);
    } SEAM(5);
#pragma unroll
    for (int layer = 0; layer < 2; ++layer) {
        const int pb = 6 + 8 * layer;
        int* cntl = args.cnt + 16 * layer;
        if (IN(pb)) { REFRAME();
            if (layer == 0) ln1_router_phase(F, args.Pre, args.in[17], args.in[18], args.ws + 5 * MiB, args.h1, args.gates, cntl, args.tok_list, args.crow_list);
            else ln1_router_phase(F, args.Pre, args.in[17] + 2 * 2048, args.in[18] + 2 * 2048, args.ws + 5 * MiB + 262144, args.h1, args.gates, cntl, args.tok_list, args.crow_list);
        } SEAM(pb);
        volatile LAS int* pre = (volatile LAS int*)(F.MISC + 16);
        if (IN(pb + 1) || IN(pb + 2)) {
            __syncthreads();
            if (F.tid < 64) {
                const int craw = F.tid < 16 ? __hip_atomic_load(cntl + F.tid, RLX_AGENT) : 0; const int c = (craw + 255) >> 8;
                if (F.tid < 16) pre[17 + F.tid] = craw;
                int incl = c;
#pragma unroll
                for (int o = 1; o < 16; o <<= 1) { const int t = __shfl_up(incl, o); if (F.tid >= o) incl += t; }
                if (F.tid < 16) pre[F.tid] = incl - c;
                if (F.tid == 15) pre[16] = incl; }
            __syncthreads();
        }
        if (IN(pb + 1)) { REFRAME();
            const int units = pre[16] * 8, rounds = (units + F.G - 1) / F.G; int Gp = rounds > 0 ? ((((units + rounds - 1) / rounds) + 7) & ~7) : F.G; if (Gp > F.G) Gp = F.G;
            if ((int)blockIdx.x < Gp) {
                fg::MoeSched S{(const char*)args.h1, (const char*)(args.Wt_gu + (size_t)layer * 16 * 2048 * 2048), (long)2048 * 2048 * 2, 2048, 2048, 8, Gp, (int)blockIdx.x, pre, cntl, args.tok_list, 1, args.ready + 16384 * layer, 0};
                fg::EpiSwiGlu E{args.hid};
                fg::gemm_phase<fg::EpiSwiGlu, fg::MoeSched, true>(F.lds, 2048, 2048, 2048, S, E);
            }
            { const int clo = layer == 0 ? 0 : MOE1_Q2, chi = layer == 0 ? MOE1_Q1 : MOE1_NIT;
              if (Gp < F.G) { if ((int)blockIdx.x >= Gp) moe1_convert_range(F, args, clo, chi, ((int)blockIdx.x - Gp) * NWAVES + F.wave, (F.G - Gp) * NWAVES); }
              else moe1_convert_range(F, args, clo, chi, F.gw, F.NGW); }
        } SEAM(pb + 1);
        if (IN(pb + 2)) { REFRAME();
            const int units = pre[16] * 8, rounds = (units + F.G - 1) / F.G; int Gp = rounds > 0 ? ((((units + rounds - 1) / rounds) + 7) & ~7) : F.G; if (Gp > F.G || layer == 1) Gp = F.G;
            if ((int)blockIdx.x < Gp) {
                fg::MoeSched S{(const char*)args.hid, (const char*)(args.Wt_dn + (size_t)layer * 16 * 2048 * 1024), (long)2048 * 1024 * 2, 1024, 1024, 8, Gp, (int)blockIdx.x, pre, cntl, args.tok_list, 0, args.ready + 16384 * layer, 0};
                fg::EpiScatter E{args.ffn, args.crow_list, pre};
                fg::gemm_phase<fg::EpiScatter, fg::MoeSched, false>(F.lds, 1024, 1024, 1024, S, E);
            }
            if (layer == 0) { if (Gp < F.G) { if ((int)blockIdx.x >= Gp) moe1_convert_range(F, args, MOE1_Q1, MOE1_Q2, ((int)blockIdx.x - Gp) * NWAVES + F.wave, (F.G - Gp) * NWAVES); }
                              else moe1_convert_range(F, args, MOE1_Q1, MOE1_Q2, F.gw, F.NGW); }
        } SEAM(pb + 2);
        if (IN(pb + 3)) { REFRAME();
            if (layer == 0) { ln2_phase<false>(F, args.h1, args.ffn, args.gates, args.in[17] + 2048, args.in[18] + 2048, (void*)args.h2); }
            else ln2_phase<true>(F, args.h1, args.ffn, args.gates, args.in[17] + 3 * 2048, args.in[18] + 3 * 2048, (void*)args.out);
        } SEAM(pb + 3);
        if (layer == 0) {
            if (IN(10)) { REFRAME();
                fg::PlainSched S{(const char*)args.h2, (const char*)args.Wt_cin, 2048, 2048, 64, 8, F.G, (int)blockIdx.x, 1 << 30, 0};
                fg::EpiBf16<0> E{args.Hc, 2048, nullptr, nullptr, 0};
                fg::gemm_phase<fg::EpiBf16<0>, fg::PlainSched, false>(F.lds, 2048, 2048, 2048, S, E);
            } SEAM(10);
            if (IN(11)) { REFRAME(); pool_phase(F, args.Hc, args.Pl); }
            if (IN(11) && IN(13)) xcd_barrier(bar);
            if (IN(13)) { REFRAME();
                fg::PlainSched S{(const char*)args.Pl, (const char*)args.Wt_cout, 2048, 2048, 64, 8, F.G, (int)blockIdx.x, 1 << 30, 0};
                fg::EpiBf16<4> E{args.Pre, 2048, nullptr, args.h2, 2048};
                fg::gemm_phase<fg::EpiBf16<4>, fg::PlainSched, false>(F.lds, 2048, 2048, 2048, S, E);
            } SEAM(13);
        }
    }
#undef IN
#undef SEAM
}
static void fill_args(Args& a, void* const* d_in, float* out, char* ws) {
    for (int i = 0; i < 24; ++i) a.in[i] = (const float*)d_in[i];
    a.out = out; a.ws = (unsigned char*)ws;
    auto at = [&](size_t mib) { return ws + mib * MiB; };
    a.bar = (unsigned*)at(0); a.cnt = (int*)(ws + 65536); a.ready = (unsigned*)(ws + 131072); a.gates = (float*)at(1); a.tok_list = (int*)at(2); a.crow_list = (int*)at(3); a.states = (float*)at(4); a.Wcin_b = (bf16_t*)at(6);
    a.Wt_in = (bf16_t*)at(16); a.Wt_out = (bf16_t*)at(36); a.Wt_cin = (bf16_t*)at(44); a.Wt_cout = (bf16_t*)at(52); a.Wt_cgrp = (bf16_t*)at(60); a.Wt_glu = (bf16_t*)at(62);
    a.Wt_gu = (bf16_t*)at(64); a.Wt_dn = (bf16_t*)at(320);
    a.xb = (bf16_t*)at(448); a.h1 = (bf16_t*)at(448); a.Hb = (bf16_t*)at(512); a.Pre = (bf16_t*)at(512); a.Vt = (bf16_t*)at(672); a.Gs = (bf16_t*)at(720);
    a.Ycat = (bf16_t*)at(736); a.Hc = (bf16_t*)at(736); a.hid = (bf16_t*)at(640); a.Pl = (bf16_t*)at(640); a.ffn = (bf16_t*)at(800); a.Yg = (bf16_t*)at(800); a.h2 = (bf16_t*)at(928);
}
}

extern "C" void kernel_launch(void* const* d_in, const int* in_sizes, int n_in, void* d_out, int out_size, void* d_ws, size_t ws_size, hipStream_t stream) {
    if (n_in != 24 || ws_size < 1024 * MiB) { fprintf(stderr, "kernel_launch: unexpected n_in %d or ws_size %zu\n", n_in, ws_size); return; }
    (void)in_sizes; (void)out_size;
    static int grid = 0;
    if (grid == 0) {
        int dev = 0, cus = 0, per_cu = 0;
        (void)hipGetDevice(&dev); (void)hipDeviceGetAttribute(&cus, hipDeviceAttributeMultiprocessorCount, dev);
        (void)hipFuncSetAttribute((const void*)mega, hipFuncAttributeMaxDynamicSharedMemorySize, LDS_BYTES);
        if (hipOccupancyMaxActiveBlocksPerMultiprocessor(&per_cu, (const void*)mega, NWAVES * 64, LDS_BYTES) != hipSuccess || per_cu < 1) { fprintf(stderr, "kernel_launch: occupancy query says %d blocks per CU\n", per_cu); per_cu = 1; }
        (void)hipGetLastError();
        grid = cus;
    }
    Args a{}; fill_args(a, d_in, (float*)d_out, (char*)d_ws);
    a.ph_lo = 0; a.ph_hi = 18; a.cmask = 31 | 128 | 256; a.pad = 0;
    (void)hipMemsetAsync(d_ws, 0, 72 * 1024, stream);
    void* kargs[] = {(void*)&a};
    hipError_t e = hipLaunchCooperativeKernel((const void*)mega, dim3(grid), dim3(NWAVES * 64), kargs, LDS_BYTES, stream);
    if (e != hipSuccess) fprintf(stderr, "kernel_launch: cooperative launch failed: %s (grid %d)\n", hipGetErrorString(e), grid);
}
```
